# Optimizing an MI355X kernel written in HIP

```python
import jax, jax.numpy as jnp
from jax import lax
import numpy as np

D_MODEL = 2048
BATCH = 2
SEQ = 16384
DEPTH = 2

HEAD_DIM = 128
ATTN_GROUPS = ((128, 1), (512, 4), (2048, 16))
ATTN_HEADS_PER_GROUP = 4
N_ATTN_GROUPS = len(ATTN_GROUPS)
N_ATTN_HEADS = N_ATTN_GROUPS * ATTN_HEADS_PER_GROUP
ATTN_WIDTH = N_ATTN_HEADS * HEAD_DIM
ATTN_OUT_WIDTH = ATTN_HEADS_PER_GROUP * HEAD_DIM
BLOCK = 128
ROPE_THETA = 10000.0
NEG_INF = -1e30

N_RET_HEADS = D_MODEL // 256
RET_QK_DIM = 256
RET_V_DIM = 512
RET_QK_WIDTH = N_RET_HEADS * RET_QK_DIM
RET_V_WIDTH = N_RET_HEADS * RET_V_DIM
CHUNK = 128
GN_EPS = 1e-5

D_FF = 5632
RMS_EPS = 1e-6

IN_SPLITS = (ATTN_WIDTH, ATTN_WIDTH, ATTN_WIDTH,
             RET_QK_WIDTH, RET_QK_WIDTH, RET_V_WIDTH, RET_V_WIDTH,
             D_MODEL, D_MODEL)
IN_COLS = sum(IN_SPLITS)

kernel_name = "hybrid_dilated_attn_retention_macaron"


def rms_norm(x, g):
    xf = x.astype(jnp.float32)
    y = xf * lax.rsqrt(jnp.mean(xf * xf, axis=-1, keepdims=True) + RMS_EPS)
    return (y * g.astype(jnp.float32)).astype(x.dtype)


def swiglu(h, w_gate, w_up, w_down):
    return (jax.nn.silu(h @ w_gate) * (h @ w_up)) @ w_down


def rope_tables(seq, dim):
    inv_freq = 1.0 / (ROPE_THETA ** (jnp.arange(0, dim, 2, dtype=jnp.float32) / dim))
    ang = jnp.arange(seq, dtype=jnp.float32)[:, None] * inv_freq[None, :]
    return jnp.cos(ang), jnp.sin(ang)


def apply_rotary(x, cos, sin):
    xf = x.astype(jnp.float32)
    half = xf.shape[-1] // 2
    x1, x2 = xf[..., :half], xf[..., half:]
    c, s = cos[:, None, :], sin[:, None, :]
    return jnp.concatenate([x1 * c - x2 * s, x2 * c + x1 * s], axis=-1)


def to_strided(x, dilation, nb):
    b, rest = x.shape[0], x.shape[2:]
    return x.reshape(b, nb * BLOCK, dilation, *rest).swapaxes(1, 2).reshape(b, dilation, nb, BLOCK, *rest)


def from_strided(x, seq):
    b, d, nb, blk = x.shape[:4]
    rest = x.shape[4:]
    return x.reshape(b, d, nb * blk, *rest).swapaxes(1, 2).reshape(b, nb * blk * d, *rest)[:, :seq]


def dilated_group_attention(q, k, v, window, dilation):
    steps = window // dilation
    b, s, h, dh = q.shape
    sub_len = -(-s // dilation)
    nb = -(-sub_len // BLOCK)
    sp = nb * BLOCK * dilation
    pad = ((0, 0), (0, sp - s), (0, 0), (0, 0))
    qs = to_strided(jnp.pad(q, pad), dilation, nb)
    ks = to_strided(jnp.pad(k, pad), dilation, nb)
    vs = to_strided(jnp.pad(v.astype(jnp.float32), pad), dilation, nb)
    prev = lambda t: jnp.pad(t, ((0, 0), (0, 0), (1, 0), (0, 0), (0, 0), (0, 0)))[:, :, :-1]
    kc = jnp.concatenate([prev(ks), ks], axis=3)
    vc = jnp.concatenate([prev(vs), vs], axis=3)
    scores = jnp.einsum('brnqhd,brnkhd->brnhqk', qs, kc)
    qi = jnp.arange(BLOCK)[:, None]
    kj = jnp.arange(2 * BLOCK)[None, :]
    blk = jnp.arange(nb)[:, None, None]
    dist = BLOCK + qi - kj
    valid = (dist >= 0) & (dist <= steps) & (blk * BLOCK + kj - BLOCK >= 0)
    valid = valid[None, None, :, None]
    scores = jnp.where(valid, scores, NEG_INF)
    m = jnp.max(scores, axis=-1, keepdims=True)
    p = jnp.where(valid, jnp.exp(scores - m), 0.0)
    l = jnp.sum(p, axis=-1)
    l_t = jnp.swapaxes(l, -1, -2)
    o = jnp.einsum('brnhqk,brnkhe->brnqhe', p, vc) / l_t[..., None]
    o = from_strided(o, s)
    m = from_strided(jnp.swapaxes(m[..., 0], -1, -2), s)
    l = from_strided(l_t, s)
    return o, m, l


def dilated_attention_mixer(q, k, v, cos, sin):
    b, s, _ = q.shape
    q = apply_rotary(q.reshape(b, s, N_ATTN_HEADS, HEAD_DIM), cos, sin) * (HEAD_DIM ** -0.5)
    k = apply_rotary(k.reshape(b, s, N_ATTN_HEADS, HEAD_DIM), cos, sin)
    v = v.reshape(b, s, N_ATTN_HEADS, HEAD_DIM)
    q = q.reshape(b, s, N_ATTN_GROUPS, ATTN_HEADS_PER_GROUP, HEAD_DIM)
    k = k.reshape(b, s, N_ATTN_GROUPS, ATTN_HEADS_PER_GROUP, HEAD_DIM)
    v = v.reshape(b, s, N_ATTN_GROUPS, ATTN_HEADS_PER_GROUP, HEAD_DIM)
    outs, maxes, dens = [], [], []
    for g, (window, dilation) in enumerate(ATTN_GROUPS):
        o, m, l = dilated_group_attention(q[:, :, g], k[:, :, g], v[:, :, g], window, dilation)
        outs.append(o)
        maxes.append(m)
        dens.append(l)
    o = jnp.stack(outs)
    m = jnp.stack(maxes)
    l = jnp.stack(dens)
    weight = l * jnp.exp(m - jnp.max(m, axis=0, keepdims=True))
    o = jnp.sum(weight[..., None] * o, axis=0) / jnp.sum(weight, axis=0)[..., None]
    return o.reshape(b, s, ATTN_OUT_WIDTH)


def retention_mixer(q, k, v, g, cos, sin):
    b, s, _ = q.shape
    n = s // CHUNK
    log_gamma = jnp.log1p(-jnp.exp2(-5.0 - jnp.arange(N_RET_HEADS, dtype=jnp.float32)))
    q = apply_rotary(q.reshape(b, s, N_RET_HEADS, RET_QK_DIM), cos, sin)
    k = apply_rotary(k.reshape(b, s, N_RET_HEADS, RET_QK_DIM), cos, sin) * (RET_QK_DIM ** -0.5)
    v = v.astype(jnp.float32).reshape(b, s, N_RET_HEADS, RET_V_DIM)
    qc = q.reshape(b, n, CHUNK, N_RET_HEADS, RET_QK_DIM)
    kc = k.reshape(b, n, CHUNK, N_RET_HEADS, RET_QK_DIM)
    vc = v.reshape(b, n, CHUNK, N_RET_HEADS, RET_V_DIM)
    idx = jnp.arange(CHUNK, dtype=jnp.float32)
    rel = idx[:, None] - idx[None, :]
    decay_mask = jnp.where(rel >= 0, jnp.exp(log_gamma[:, None, None] * jnp.maximum(rel, 0.0)), 0.0)
    inner = jnp.einsum('bnihd,bnjhd->bnhij', qc, kc) * decay_mask
    o_inner = jnp.einsum('bnhij,bnjhe->bnihe', inner, vc)
    q_dec = qc * jnp.exp(log_gamma[None, :] * (idx + 1.0)[:, None])[:, :, None]
    k_dec = kc * jnp.exp(log_gamma[None, :] * (CHUNK - 1.0 - idx)[:, None])[:, :, None]
    chunk_decay = jnp.exp(log_gamma * CHUNK)[None, :, None, None]

    def step(state, xs):
        qn, kn, vn = xs
        out = jnp.einsum('bihd,bhde->bihe', qn, state)
        state = chunk_decay * state + jnp.einsum('bjhd,bjhe->bhde', kn, vn)
        return state, out

    state0 = jnp.zeros((b, N_RET_HEADS, RET_QK_DIM, RET_V_DIM), jnp.float32)
    _, o_cross = lax.scan(step, state0, (q_dec.swapaxes(0, 1), k_dec.swapaxes(0, 1), vc.swapaxes(0, 1)))
    o = (o_inner + o_cross.swapaxes(0, 1)).reshape(b, s, N_RET_HEADS, RET_V_DIM)
    mu = jnp.mean(o, axis=-1, keepdims=True)
    var = jnp.mean(jnp.square(o - mu), axis=-1, keepdims=True)
    o = (o - mu) * lax.rsqrt(var + GN_EPS)
    gate = jax.nn.silu(g.astype(jnp.float32)).reshape(b, s, N_RET_HEADS, RET_V_DIM)
    return (o * gate).reshape(b, s, RET_V_WIDTH)


def setup_inputs(seed: int = 0) -> dict:
    key = jax.random.key(seed)
    ks = jax.random.split(key, 16)

    def w(k, shape, fan_in):
        return jax.random.normal(k, shape, jnp.float32) * (fan_in ** -0.5)

    def gain(k, shape):
        return 1.0 + 0.01 * jax.random.normal(k, shape, jnp.float32)

    return {
        "x": jax.random.normal(ks[0], (BATCH, SEQ, D_MODEL), jnp.float32),
        "ffn1_norm": gain(ks[1], (DEPTH, D_MODEL)),
        "ffn1_w_gate": w(ks[2], (DEPTH, D_MODEL, D_FF), D_MODEL),
        "ffn1_w_up": w(ks[3], (DEPTH, D_MODEL, D_FF), D_MODEL),
        "ffn1_w_down": w(ks[4], (DEPTH, D_FF, D_MODEL), D_FF),
        "mix_norm": gain(ks[5], (DEPTH, D_MODEL)),
        "w_in": w(ks[6], (DEPTH, D_MODEL, IN_COLS), D_MODEL),
        "w_proj_attn": w(ks[7], (DEPTH, ATTN_OUT_WIDTH, D_MODEL), ATTN_OUT_WIDTH),
        "w_proj_ret": w(ks[8], (DEPTH, RET_V_WIDTH, D_MODEL), RET_V_WIDTH),
        "w_out": w(ks[9], (DEPTH, D_MODEL, D_MODEL), D_MODEL),
        "ffn2_norm": gain(ks[10], (DEPTH, D_MODEL)),
        "ffn2_w_gate": w(ks[11], (DEPTH, D_MODEL, D_FF), D_MODEL),
        "ffn2_w_up": w(ks[12], (DEPTH, D_MODEL, D_FF), D_MODEL),
        "ffn2_w_down": w(ks[13], (DEPTH, D_FF, D_MODEL), D_FF),
        "final_norm": gain(ks[14], (D_MODEL,)),
    }


def reference(x, ffn1_norm, ffn1_w_gate, ffn1_w_up, ffn1_w_down, mix_norm, w_in,
              w_proj_attn, w_proj_ret, w_out, ffn2_norm, ffn2_w_gate, ffn2_w_up,
              ffn2_w_down, final_norm):
    seq = x.shape[1]
    cos_a, sin_a = rope_tables(seq, HEAD_DIM)
    cos_r, sin_r = rope_tables(seq, RET_QK_DIM)
    offsets = [int(o) for o in np.cumsum(IN_SPLITS)[:-1]]
    for layer in range(DEPTH):
        x = x + 0.5 * swiglu(rms_norm(x, ffn1_norm[layer]), ffn1_w_gate[layer],
                             ffn1_w_up[layer], ffn1_w_down[layer])
        h = rms_norm(x, mix_norm[layer])
        proj = h @ w_in[layer]
        q_a, k_a, v_a, q_r, k_r, v_r, g_r, gate_a, gate_b = jnp.split(proj, offsets, axis=-1)
        o_a = dilated_attention_mixer(q_a, k_a, v_a, cos_a, sin_a).astype(x.dtype)
        o_r = retention_mixer(q_r, k_r, v_r, g_r, cos_r, sin_r).astype(x.dtype)
        merged = (jax.nn.sigmoid(gate_a) * (o_a @ w_proj_attn[layer])
                  + jax.nn.sigmoid(gate_b) * (o_r @ w_proj_ret[layer]))
        x = x + merged @ w_out[layer]
        x = x + 0.5 * swiglu(rms_norm(x, ffn2_norm[layer]), ffn2_w_gate[layer],
                             ffn2_w_up[layer], ffn2_w_down[layer])
    return rms_norm(x, final_norm)
```

```cpp
#include <hip/hip_runtime.h>
#include <cstdio>
#include <cstdint>

namespace pg8 {
#define PG8_LAS __attribute__((address_space(3)))
typedef unsigned short bf16_t;
typedef short bf16x8 __attribute__((ext_vector_type(8)));
typedef float f32x4 __attribute__((ext_vector_type(4)));
typedef unsigned u32x4 __attribute__((ext_vector_type(4)));
constexpr int BM = 256, BK = 64, HALF = 128, HTB = HALF * BK * 2, STAGE_BYTES = 8 * HTB, NXCD = 8, WGM = 8;

__host__ __device__ __forceinline__ int lds_byte(int r, int c) { const int st = (r >> 4) * 2 + (c >> 5), rr = r & 15, cc = c & 31, ob = rr * 64 + cc * 2; return st * 1024 + (ob ^ (((ob >> 9) & 1) << 5)); }
__host__ __device__ __forceinline__ void stage_rc(int b, int& R, int& C) { const int st = b / 1024, sb = b % 1024, swz = sb ^ (((sb >> 9) & 1) << 5); R = (st >> 1) * 16 + swz / 64; C = (st & 1) * 32 + (swz % 64) / 2; }
__host__ __device__ __forceinline__ int perm32(int rho) { const int n = rho >> 4, i = rho & 15; return 8 * (i >> 2) + 4 * n + (i & 3); }

struct Unit { int pm, pn; };
struct Gemm { const bf16_t* A; const bf16_t* Bt; int M, N, K; int a_tiled = 0; };

struct StaticOrder {
    int nM, nN, nwg, G, c, wgm, rev;
    __host__ __device__ void init(int M, int N, int G_, int c_, int wgm_ = WGM, int rev_ = 0) { nM = M / BM; nN = N / BM; nwg = nM * nN; G = G_; c = c_; wgm = wgm_; rev = rev_; }
    __host__ __device__ bool next(int i, Unit& u) const {
        const long L = (long)i * G + c; if (L >= nwg) return false;
        int wgid = (int)L; { const int q = nwg / NXCD, r = nwg % NXCD, xcd = wgid % NXCD, off = wgid / NXCD; wgid = (xcd < r ? xcd * (q + 1) : r * (q + 1) + (xcd - r) * q) + off; }
        const int nig = wgm * nN, gid = wgid / nig, fm = gid * wgm, gsz = (nM - fm) < wgm ? (nM - fm) : wgm;
        u.pm = fm + ((wgid % nig) % gsz); u.pn = (wgid % nig) / gsz; if (rev) u.pm = nM - 1 - u.pm; return true;
    }
    __device__ __forceinline__ void a_ready(const Unit&) const {}
    __device__ __forceinline__ void done(const Unit&) const {}
};

typedef float f32x2_t __attribute__((ext_vector_type(2))); typedef double f64x2_t __attribute__((ext_vector_type(2))); typedef __bf16 bf16x2_t __attribute__((ext_vector_type(2)));
__device__ __forceinline__ unsigned cvt_pk_bf16(float lo, float hi) { f32x2_t v = {lo, hi}; bf16x2_t b = __builtin_convertvector(v, bf16x2_t); return __builtin_bit_cast(unsigned, b); }
#define PG8_SWAP_PAIR(op, v, x, y) unsigned x, y; { unsigned b_; asm volatile("v_mov_b32 %0, %1" : "=v"(b_) : "v"(__builtin_bit_cast(unsigned, v))); \
        const auto r_ = __builtin_amdgcn_##op(__builtin_bit_cast(unsigned, v), b_, false, false); x = r_[0]; y = r_[1]; asm volatile("" : "+v"(x)); asm volatile("" : "+v"(y)); }
__device__ __forceinline__ float xor16_sum(float v) { PG8_SWAP_PAIR(permlane16_swap, v, x, y) return __builtin_bit_cast(float, x) + __builtin_bit_cast(float, y); }
__device__ __forceinline__ float xor32_sum(float v) { PG8_SWAP_PAIR(permlane32_swap, v, x, y) return __builtin_bit_cast(float, x) + __builtin_bit_cast(float, y); }
__device__ __forceinline__ float xor16_max(float v) { PG8_SWAP_PAIR(permlane16_swap, v, x, y) return __builtin_fmaxf(__builtin_bit_cast(float, x), __builtin_bit_cast(float, y)); }
__device__ __forceinline__ float xor32_max(float v) { PG8_SWAP_PAIR(permlane32_swap, v, x, y) return __builtin_fmaxf(__builtin_bit_cast(float, x), __builtin_bit_cast(float, y)); }
__device__ __forceinline__ float fast_sigmoid(float x) { return __builtin_amdgcn_rcpf(1.0f + __builtin_amdgcn_exp2f(-1.44269504089f * x)); }

constexpr float SSQ_FIX = 65536.0f;
constexpr int SSQ_LDS_OFF = 131072;
typedef const PG8_LAS unsigned long long* ssq_lds_t;
#define PG8_ROW_RSTD(rs, rl, r0) float rs[2][4]; _Pragma("unroll") for (int ai_ = 0; ai_ < 2; ++ai_) _Pragma("unroll") for (int m_ = 0; m_ < 4; ++m_) \
        rs[ai_][m_] = __builtin_amdgcn_rsqf((float)rl[(r0) + ai_ * HALF + m_ * 16] * (1.0f / (SSQ_FIX * 2048.0f)) + 1e-6f);


struct EpiGateUp {
    static constexpr bool PERM = true, AFTER_DRAIN = false, ROWNORM = true, HAS_PRE = false;
    bf16_t* O; int ldc; const unsigned long long* ssq;
    __device__ __forceinline__ void operator()(const f32x4 (&acc)[2][2][4][2], const Unit& u, int wr, int wc, int fr, int fq, ssq_lds_t rl) const {
        const int row0 = u.pm * BM + wr * 64 + fr, col0 = u.pn * HALF + wc * 32 + 8 * fq;
        PG8_ROW_RSTD(rs, rl, wr * 64 + fr)
#pragma unroll
        for (int ai = 0; ai < 2; ++ai)
#pragma unroll
            for (int m = 0; m < 4; ++m) {
                bf16_t* rowp = O + (((size_t)u.pm * (ldc >> 6) + 2 * u.pn + (wc >> 1)) * BM + (wr * 64 + fr + ai * HALF + m * 16)) * BK + (wc & 1) * 32 + 8 * fq;
                float h[8];
#pragma unroll
                for (int n = 0; n < 2; ++n)
#pragma unroll
                    for (int j = 0; j < 4; ++j) { const float g = acc[ai][0][m][n][j] * rs[ai][m], up = acc[ai][1][m][n][j] * rs[ai][m]; h[n * 4 + j] = g * fast_sigmoid(g) * up; }
                u32x4 w; w.x = cvt_pk_bf16(h[0], h[1]); w.y = cvt_pk_bf16(h[2], h[3]); w.z = cvt_pk_bf16(h[4], h[5]); w.w = cvt_pk_bf16(h[6], h[7]);
                __builtin_nontemporal_store(w, (u32x4*)rowp);
            }
    }
};
struct EpiRes {
    static constexpr bool PERM = true, AFTER_DRAIN = false, ROWNORM = false;
    const bf16_t* base; bf16_t* out; int ldc; float scale; unsigned long long* ssq_out;
    static constexpr bool HAS_PRE = true;
    struct Pre { u32x4 b[2][4][2]; };
    __device__ __forceinline__ void preload(Pre& P, const Unit& u, int wr, int wc, int fr, int fq) const {
        const int row0 = u.pm * BM + wr * 64 + fr, col0 = u.pn * BM + wc * 32 + 8 * fq;
#pragma unroll
        for (int ai = 0; ai < 2; ++ai)
#pragma unroll
            for (int m = 0; m < 4; ++m)
#pragma unroll
                for (int bj = 0; bj < 2; ++bj) P.b[ai][m][bj] = *(const u32x4*)(base + (size_t)(row0 + ai * HALF + m * 16) * ldc + col0 + bj * HALF);
    }
    __device__ __forceinline__ void operator()(const f32x4 (&acc)[2][2][4][2], const Unit& u, int wr, int wc, int fr, int fq, ssq_lds_t rl, const Pre& P) const {
        const int row0 = u.pm * BM + wr * 64 + fr, col0 = u.pn * BM + wc * 32 + 8 * fq;
        float ss[2][4];
#pragma unroll
        for (int ai = 0; ai < 2; ++ai)
#pragma unroll
            for (int m = 0; m < 4; ++m) {
                const size_t off = (size_t)(row0 + ai * HALF + m * 16) * ldc + col0;
                float sq = 0.f;
#pragma unroll
                for (int bj = 0; bj < 2; ++bj) {
                    const u32x4 bb = P.b[ai][m][bj];
                    const f32x4 a0 = acc[ai][bj][m][0] * scale, a1 = acc[ai][bj][m][1] * scale;
                    float y[8];
#pragma unroll
                    for (int q = 0; q < 4; ++q) { const f32x4 a = q < 2 ? a0 : a1; y[2 * q] = __builtin_bit_cast(float, bb[q] << 16) + a[(q & 1) * 2]; y[2 * q + 1] = __builtin_bit_cast(float, bb[q] & 0xffff0000u) + a[(q & 1) * 2 + 1]; }
#pragma unroll
                    for (int q = 0; q < 8; ++q) sq += y[q] * y[q];
                    u32x4 w; w.x = cvt_pk_bf16(y[0], y[1]); w.y = cvt_pk_bf16(y[2], y[3]); w.z = cvt_pk_bf16(y[4], y[5]); w.w = cvt_pk_bf16(y[6], y[7]);
                    *(u32x4*)(out + off + bj * HALF) = w;
                }
                ss[ai][m] = sq;
            }
#pragma unroll
        for (int ai = 0; ai < 2; ++ai)
#pragma unroll
            for (int m = 0; m < 4; ++m) ss[ai][m] = xor32_sum(xor16_sum(ss[ai][m]));
        if (fq == 0) {
#pragma unroll
            for (int ai = 0; ai < 2; ++ai)
#pragma unroll
                for (int m = 0; m < 4; ++m) atomicAdd(ssq_out + (row0 + ai * HALF + m * 16), (unsigned long long)(unsigned)fminf(ss[ai][m] * SSQ_FIX, 4.0e9f));
        }
    }
};
struct EpiInA {
    static constexpr bool PERM = true, AFTER_DRAIN = false, ROWNORM = true, HAS_PRE = false;
    bf16_t* QKV; size_t sec_stride; const float *cosa, *sina; int seq; const unsigned long long* ssq;
    __device__ __forceinline__ void operator()(const f32x4 (&acc)[2][2][4][2], const Unit& u, int wr, int wc, int fr, int fq, ssq_lds_t rl) const {
        const int sec = u.pn / 6, hp = u.pn - sec * 6;
        bf16_t* O = QKV + (size_t)sec * sec_stride;
        const int row0 = u.pm * BM + wr * 64 + fr, col0 = hp * BM + wc * 32 + 8 * fq;
        const float sc0 = sec == 0 ? 0.08838834764831845f : 1.0f;
        const int i0 = wc * 16 + fq * 4;
        PG8_ROW_RSTD(rs, rl, wr * 64 + fr)
        if (sec < 2) {
#pragma unroll
            for (int ai = 0; ai < 2; ++ai) {
                f32x4 cs[4][2];
#pragma unroll
                for (int m = 0; m < 4; ++m) {
                    const int t = (row0 + ai * HALF + m * 16) % seq;
                    cs[m][0] = *(const f32x4*)(cosa + (size_t)t * 64 + i0); cs[m][1] = *(const f32x4*)(sina + (size_t)t * 64 + i0);
                }
#pragma unroll
                for (int m = 0; m < 4; ++m) {
                    bf16_t* rowp = O + (size_t)(row0 + ai * HALF + m * 16) * 1536 + col0;
                    const float sc = sc0 * rs[ai][m];
                    const f32x4 c = cs[m][0], sn = cs[m][1];
#pragma unroll
                    for (int bj = 0; bj < 2; ++bj) {
                        const f32x4 x1 = acc[ai][bj][m][0], x2 = acc[ai][bj][m][1];
                        const f32x4 y1 = (x1 * c - x2 * sn) * sc, y2 = (x2 * c + x1 * sn) * sc;
                        u32x4 w; w.x = cvt_pk_bf16(y1[0], y1[1]); w.y = cvt_pk_bf16(y1[2], y1[3]); w.z = cvt_pk_bf16(y2[0], y2[1]); w.w = cvt_pk_bf16(y2[2], y2[3]);
                        __builtin_nontemporal_store(w, (u32x4*)(rowp + bj * HALF));
                    }
                }
            }
        } else {
#pragma unroll
            for (int ai = 0; ai < 2; ++ai)
#pragma unroll
                for (int m = 0; m < 4; ++m) {
                    bf16_t* rowp = O + (size_t)(row0 + ai * HALF + m * 16) * 1536 + col0;
                    const float sc = rs[ai][m];
#pragma unroll
                    for (int bj = 0; bj < 2; ++bj) {
                        const f32x4 v0 = acc[ai][bj][m][0] * sc, v1 = acc[ai][bj][m][1] * sc;
                        u32x4 w; w.x = cvt_pk_bf16(v0[0], v0[1]); w.y = cvt_pk_bf16(v0[2], v0[3]); w.z = cvt_pk_bf16(v1[0], v1[1]); w.w = cvt_pk_bf16(v1[2], v1[3]);
                        __builtin_nontemporal_store(w, (u32x4*)(rowp + bj * HALF));
                    }
                }
        }
    }
};
struct EpiInR {
    static constexpr bool PERM = true, AFTER_DRAIN = false, ROWNORM = true, HAS_PRE = false;
    bf16_t* QK; size_t qk_stride; bf16_t* VG; size_t vg_stride; const float *cosr, *sinr; int seq; const unsigned long long* ssq;
    __device__ __forceinline__ void operator()(const f32x4 (&acc)[2][2][4][2], const Unit& u, int wr, int wc, int fr, int fq, ssq_lds_t rl) const {
        const int pn = u.pn;
        const int row0 = u.pm * BM + wr * 64 + fr;
        PG8_ROW_RSTD(rs, rl, wr * 64 + fr)
        if (pn < 16) {
            bf16_t* O = QK + (size_t)(pn >> 3) * qk_stride; const int head = pn & 7; const float sc0 = pn < 8 ? 1.0f : 0.0625f;
            const int col0 = wc * 32 + 8 * fq;
#pragma unroll
            for (int aim = 0; aim < 4; ++aim) {
              const int ai = aim >> 1;
              f32x4 cs[2][2][2];
#pragma unroll
              for (int mm = 0; mm < 2; ++mm) {
                  const int t = (row0 + ai * HALF + ((aim & 1) * 2 + mm) * 16) % seq;
#pragma unroll
                  for (int bj = 0; bj < 2; ++bj) { const int i0 = bj * 64 + wc * 16 + fq * 4; cs[mm][bj][0] = *(const f32x4*)(cosr + (size_t)t * 128 + i0); cs[mm][bj][1] = *(const f32x4*)(sinr + (size_t)t * 128 + i0); }
              }
#pragma unroll
                for (int mm = 0; mm < 2; ++mm) {
                    const int m = (aim & 1) * 2 + mm;
                    const int row = row0 + ai * HALF + m * 16; const int bb = row / seq, t = row - bb * seq;
                    bf16_t* rowp = O + ((size_t)(bb * 8 + head) * seq + t) * 256 + col0;
                    if (pn < 8) rowp = O + ((size_t)(bb * 8 + head) * seq + (t - fr)) * 256 + wc * 512 + (16 * fq + fr) * 8;
                    const float sc = sc0 * rs[ai][m];
#pragma unroll
                    for (int bj = 0; bj < 2; ++bj) {
                        const f32x4 c = cs[mm][bj][0], s = cs[mm][bj][1];
                        const f32x4 x1 = acc[ai][bj][m][0], x2 = acc[ai][bj][m][1];
                        const f32x4 y1 = (x1 * c - x2 * s) * sc, y2 = (x2 * c + x1 * s) * sc;
                        u32x4 w; w.x = cvt_pk_bf16(y1[0], y1[1]); w.y = cvt_pk_bf16(y1[2], y1[3]); w.z = cvt_pk_bf16(y2[0], y2[1]); w.w = cvt_pk_bf16(y2[2], y2[3]);
                        __builtin_nontemporal_store(w, (u32x4*)(rowp + bj * (pn < 8 ? 4 * 512 : HALF)));
                    }
                }
            }
        } else {
            const int ct = pn - 16, head = ct >> 1;
#pragma unroll
            for (int ai = 0; ai < 2; ++ai)
#pragma unroll
                for (int m = 0; m < 4; ++m) {
                    const int row = row0 + ai * HALF + m * 16; const int bb = row / seq, t = row - bb * seq;
#pragma unroll
                    for (int bj = 0; bj < 2; ++bj) {
                        const int sl = (ct & 1) * 8 + bj * 4 + wc;
                        bf16_t* p = VG + (((size_t)(bb * 8 + head) * 16 + sl) * seq + t) * 32 + 8 * fq;
                        const f32x4 v0 = acc[ai][bj][m][0] * rs[ai][m], v1 = acc[ai][bj][m][1] * rs[ai][m];
                        u32x4 w; w.x = cvt_pk_bf16(v0[0], v0[1]); w.y = cvt_pk_bf16(v0[2], v0[3]); w.z = cvt_pk_bf16(v1[0], v1[1]); w.w = cvt_pk_bf16(v1[2], v1[3]);
                        __builtin_nontemporal_store(w, (u32x4*)p);
                    }
                }
        }
    }
};
struct EpiGates {
    static constexpr bool PERM = true, AFTER_DRAIN = false, ROWNORM = true, HAS_PRE = false;
    bf16_t* GAB; size_t g_stride; const unsigned long long* ssq;
    __device__ __forceinline__ void operator()(const f32x4 (&acc)[2][2][4][2], const Unit& u, int wr, int wc, int fr, int fq, ssq_lds_t rl) const {
        bf16_t* O = GAB + (size_t)(u.pn >> 3) * g_stride; const int ct = u.pn & 7;
        const int row0 = u.pm * BM + wr * 64 + fr, col0 = ct * BM + wc * 32 + 8 * fq;
        PG8_ROW_RSTD(rs, rl, wr * 64 + fr)
#pragma unroll
        for (int ai = 0; ai < 2; ++ai)
#pragma unroll
            for (int m = 0; m < 4; ++m) {
                bf16_t* rowp = O + (size_t)(row0 + ai * HALF + m * 16) * 2048 + col0;
#pragma unroll
                for (int bj = 0; bj < 2; ++bj) {
                    f32x4 v0 = acc[ai][bj][m][0] * rs[ai][m], v1 = acc[ai][bj][m][1] * rs[ai][m];
#pragma unroll
                    for (int j = 0; j < 4; ++j) { v0[j] = fast_sigmoid(v0[j]); v1[j] = fast_sigmoid(v1[j]); }
                    u32x4 w; w.x = cvt_pk_bf16(v0[0], v0[1]); w.y = cvt_pk_bf16(v0[2], v0[3]); w.z = cvt_pk_bf16(v1[0], v1[1]); w.w = cvt_pk_bf16(v1[2], v1[3]);
                    __builtin_nontemporal_store(w, (u32x4*)(rowp + bj * HALF));
                }
            }
    }
};
struct EpiG {
    static constexpr bool PERM = true, AFTER_DRAIN = false, ROWNORM = true, HAS_PRE = false;
    static constexpr int seq = 16384;
    const bf16_t* OP; bf16_t* O; const unsigned long long* st; const unsigned long long* ssq;
    __device__ __forceinline__ void operator()(const f32x4 (&acc)[2][2][4][2], const Unit& u, int wr, int wc, int fr, int fq, ssq_lds_t rl) const {
        const int pn = u.pn, head = pn >> 1;
        const int row0 = u.pm * BM + wr * 64 + fr;
        PG8_ROW_RSTD(rs, rl, wr * 64 + fr)
#pragma unroll
        for (int ai = 0; ai < 2; ++ai) {
            u32x4 ov[4][2]; f32x2_t sv[4];
#pragma unroll
            for (int mm = 0; mm < 4; ++mm) {
                const int row = row0 + ai * HALF + mm * 16; const int bb = row / seq, t = row - bb * seq;
                { const u32x4 q4 = *(const u32x4*)(st + ((size_t)row * 8 + head) * 2);
                  const float m1 = (float)(long long)(((unsigned long long)q4.y << 32) | q4.x) * (1.0f / (1048576.0f * 512.0f)), m2 = (float)(((unsigned long long)q4.w << 32) | q4.z) * (1.0f / (1048576.0f * 512.0f));
                  sv[mm].x = m1; sv[mm].y = __builtin_amdgcn_rsqf(__builtin_fmaxf(m2 - m1 * m1, 0.f) + 1e-5f); }
#pragma unroll
                for (int bj = 0; bj < 2; ++bj) { const int sl = (pn & 1) * 8 + bj * 4 + wc; ov[mm][bj] = *(const u32x4*)(OP + (((size_t)(bb * 8 + head) * 16 + sl) * seq + t) * 32 + 8 * fq); }
            }
#pragma unroll
            for (int mm = 0; mm < 4; ++mm) {
                const int m = mm;
                bf16_t* rowp = O + (size_t)(row0 + ai * HALF + m * 16) * 4096 + pn * BM + wc * 32 + 8 * fq;
                const float r = rs[ai][m], mu = sv[mm].x, rg = sv[mm].y;
#pragma unroll
                for (int bj = 0; bj < 2; ++bj) {
                    float y[8];
#pragma unroll
                    for (int q = 0; q < 4; ++q) {
                        const int n = q >> 1, j = (q & 1) * 2;
                        const float g0 = acc[ai][bj][m][n][j] * r, g1 = acc[ai][bj][m][n][j + 1] * r;
                        const float o0 = __builtin_bit_cast(float, ov[mm][bj][q] << 16), o1 = __builtin_bit_cast(float, ov[mm][bj][q] & 0xffff0000u);
                        y[2 * q] = (o0 - mu) * rg * (g0 * fast_sigmoid(g0)); y[2 * q + 1] = (o1 - mu) * rg * (g1 * fast_sigmoid(g1));
                    }
                    u32x4 w; w.x = cvt_pk_bf16(y[0], y[1]); w.y = cvt_pk_bf16(y[2], y[3]); w.z = cvt_pk_bf16(y[4], y[5]); w.w = cvt_pk_bf16(y[6], y[7]);
                    __builtin_nontemporal_store(w, (u32x4*)(rowp + bj * HALF));
                }
            }
        }
    }
};
struct EpiGated {
    static constexpr bool PERM = true, AFTER_DRAIN = false, ROWNORM = false, HAS_PRE = false;
    const bf16_t* gate; const bf16_t* add; bf16_t* out; int ldc;
    __device__ __forceinline__ void operator()(const f32x4 (&acc)[2][2][4][2], const Unit& u, int wr, int wc, int fr, int fq, ssq_lds_t rl) const {
        const int row0 = u.pm * BM + wr * 64 + fr, col0 = u.pn * BM + wc * 32 + 8 * fq;
#pragma unroll
        for (int ai = 0; ai < 2; ++ai) {
            u32x4 gv[4][2], av[4][2];
#pragma unroll
            for (int m = 0; m < 4; ++m)
#pragma unroll
                for (int bj = 0; bj < 2; ++bj) gv[m][bj] = *(const u32x4*)(gate + (size_t)(row0 + ai * HALF + m * 16) * ldc + col0 + bj * HALF);
            if (add) {
#pragma unroll
                for (int m = 0; m < 4; ++m)
#pragma unroll
                    for (int bj = 0; bj < 2; ++bj) av[m][bj] = *(const u32x4*)(add + (size_t)(row0 + ai * HALF + m * 16) * ldc + col0 + bj * HALF);
            } else {
#pragma unroll
                for (int m = 0; m < 4; ++m)
#pragma unroll
                    for (int bj = 0; bj < 2; ++bj) av[m][bj] = (u32x4){0u, 0u, 0u, 0u};
            }
#pragma unroll
            for (int m = 0; m < 4; ++m) {
                const size_t off = (size_t)(row0 + ai * HALF + m * 16) * ldc + col0;
#pragma unroll
                for (int bj = 0; bj < 2; ++bj) {
                    float r[8];
#pragma unroll
                    for (int q = 0; q < 4; ++q) {
                        const float g0 = __builtin_bit_cast(float, gv[m][bj][q] << 16), g1 = __builtin_bit_cast(float, gv[m][bj][q] & 0xffff0000u);
                        const float a0 = __builtin_bit_cast(float, av[m][bj][q] << 16), a1 = __builtin_bit_cast(float, av[m][bj][q] & 0xffff0000u);
                        const int n = q >> 1, j = (q & 1) * 2;
                        r[2 * q] = a0 + g0 * acc[ai][bj][m][n][j]; r[2 * q + 1] = a1 + g1 * acc[ai][bj][m][n][j + 1];
                    }
                    u32x4 w; w.x = cvt_pk_bf16(r[0], r[1]); w.y = cvt_pk_bf16(r[2], r[3]); w.z = cvt_pk_bf16(r[4], r[5]); w.w = cvt_pk_bf16(r[6], r[7]);
                    *(u32x4*)(out + off + bj * HALF) = w;
                }
            }
        }
    }
};

template <class Epi, class Sched, bool ALIGN_EPI = true, bool SP2 = true>
__device__ __forceinline__ void gemm_phase(PG8_LAS unsigned char* lds, const int tid, const Gemm g, const Sched& S, const Epi& E) {
    const int wid = __builtin_amdgcn_readfirstlane(tid >> 6), lane = tid & 63, wr = wid >> 2, wc = wid & 3, fr = lane & 15, fq = lane >> 4;
    const int K = g.K, nt = K / BK;
    unsigned voffA[2], voffB[2];
#pragma unroll
    for (int i = 0; i < 2; ++i) { int R, C; stage_rc(tid * 16 + i * 8192, R, C); const int Rb = Epi::PERM ? ((R & ~31) + perm32(R & 31)) : R;
        voffA[i] = (unsigned)(R * (g.a_tiled ? BK : K) + C) * 2u; voffB[i] = (unsigned)(Rb * BK + C) * 2u; }
    const size_t kstep = (size_t)(BK * 2);
    const size_t hstep = (size_t)HALF * K * 2;
    const size_t tstep = 2 * hstep;
    const size_t kstepB = (size_t)BM * BK * 2, hstepB = (size_t)HALF * BK * 2;
    const size_t kstepA = g.a_tiled ? (size_t)BM * BK * 2 : kstep, hstepA = g.a_tiled ? (size_t)HALF * BK * 2 : hstep;
    const unsigned ldsw = (unsigned)wid * 1024u;
    const int aoff = lds_byte(wr * 64 + fr, fq * 8), boff = lds_byte(wc * 32 + fr, fq * 8);
#define PG8_SA(b, h) (((b) * 2 + (h)) * HTB)
#define PG8_SB(b, h) ((4 + (b) * 2 + (h)) * HTB)
#define PG8_STAGE(bufoff, gbase, voff) do { _Pragma("unroll") for (int _i = 0; _i < 2; ++_i) \
        __builtin_amdgcn_global_load_lds((const unsigned*)((const char*)(gbase) + (voff)[_i]), (PG8_LAS unsigned*)(lds + (bufoff) + ldsw + _i * 8192), 16, 0, 0); } while (0)
#define PG8_LDA(dst, b, h) do { _Pragma("unroll") for (int m = 0; m < 4; ++m) _Pragma("unroll") for (int k = 0; k < 2; ++k) dst[m][k] = *(const PG8_LAS bf16x8*)(lds + PG8_SA(b, h) + aoff + m * 2048 + k * 1024); } while (0)
#define PG8_LDB(dst, b, h) do { _Pragma("unroll") for (int n = 0; n < 2; ++n) _Pragma("unroll") for (int k = 0; k < 2; ++k) dst[n][k] = *(const PG8_LAS bf16x8*)(lds + PG8_SB(b, h) + boff + n * 2048 + k * 1024); } while (0)
#define PG8_MMA(ai, bj, At, Bt) do { __builtin_amdgcn_s_setprio(1); _Pragma("unroll") for (int m = 0; m < 4; ++m) _Pragma("unroll") for (int n = 0; n < 2; ++n) _Pragma("unroll") for (int k = 0; k < 2; ++k) \
        acc[ai][bj][m][n] = __builtin_amdgcn_mfma_f32_16x16x32_bf16(Bt[n][k], At[m][k], acc[ai][bj][m][n], 0, 0, 0); __builtin_amdgcn_s_setprio(0); } while (0)
#define PG8_WAIT_V(n) asm volatile("s_waitcnt vmcnt(" #n ")" ::: "memory")
#define PG8_WAIT_L(n) asm volatile("s_waitcnt lgkmcnt(" #n ")" ::: "memory")
#define PG8_BAR __builtin_amdgcn_s_barrier()
#define PG8_SCHED __builtin_amdgcn_sched_barrier(0)
    Unit cur, nxt; int ui = 0;
    if (!S.next(0, cur)) return;
    f32x4 acc[2][2][4][2];
#pragma unroll
    for (int a = 0; a < 2; ++a)
#pragma unroll
        for (int b = 0; b < 2; ++b)
#pragma unroll
            for (int m = 0; m < 4; ++m)
#pragma unroll
                for (int n = 0; n < 2; ++n) { f64x2_t z; asm volatile("v_mov_b64 %0, 0" : "=v"(z.x)); asm volatile("v_mov_b64 %0, 0" : "=v"(z.y)); acc[a][b][m][n] = __builtin_bit_cast(f32x4, z); }
    bf16x8 At[4][2], B0[2][2], B1[2][2];
    const char* cA = (const char*)g.A + (size_t)cur.pm * tstep; const char* cB = (const char*)g.Bt + (size_t)cur.pn * tstep;
    S.a_ready(cur);
    if constexpr (SP2) {
        PG8_STAGE(PG8_SB(0, 0), cB, voffB); PG8_STAGE(PG8_SB(0, 1), cB + hstepB, voffB); PG8_STAGE(PG8_SA(0, 0), cA, voffA); PG8_STAGE(PG8_SA(0, 1), cA + hstepA, voffA);
        if (wr == 1) PG8_BAR;
        PG8_WAIT_V(2); PG8_BAR;
        PG8_STAGE(PG8_SB(1, 0), cB + kstepB, voffB); PG8_STAGE(PG8_SA(1, 0), cA + kstepA, voffA); PG8_STAGE(PG8_SB(1, 1), cB + hstepB + kstepB, voffB);
        PG8_WAIT_V(6); PG8_BAR;
    } else {
        PG8_STAGE(PG8_SB(0, 0), cB, voffB); PG8_STAGE(PG8_SA(0, 0), cA, voffA); PG8_STAGE(PG8_SB(0, 1), cB + hstepB, voffB); PG8_STAGE(PG8_SA(0, 1), cA + hstepA, voffA);
        if (wr == 1) PG8_BAR;
        PG8_WAIT_V(4); PG8_BAR;
        PG8_STAGE(PG8_SB(1, 0), cB + kstepB, voffB); PG8_STAGE(PG8_SA(1, 0), cA + kstepA, voffA); PG8_STAGE(PG8_SB(1, 1), cB + hstepB + kstepB, voffB);
        PG8_WAIT_V(6); PG8_BAR;
    }
    for (;;) {
        const bool has_next = S.next(ui + 1, nxt);
        const char* nA = has_next ? (const char*)g.A + (size_t)nxt.pm * tstep : cA; const char* nB = has_next ? (const char*)g.Bt + (size_t)nxt.pn * tstep : cB;
        if constexpr (Epi::ROWNORM) __builtin_amdgcn_global_load_lds((const unsigned*)(E.ssq + (size_t)cur.pm * BM) + wid * 64 + lane, (PG8_LAS unsigned*)(lds + SSQ_LDS_OFF + (ui & 1) * 2048 + wid * 256), 4, 0, 0);
        for (int t = 0; t < nt; t += 2) {
            const bool last = (t == nt - 2);
            const char* a1 = cA + (size_t)(t + 1) * kstepA;
            const char* a2 = last ? nA : cA + (size_t)(t + 2) * kstepA; const char* b2 = last ? nB : cB + (size_t)(t + 2) * kstepB;
            const char* a3 = a2 + kstepA; const char* b3 = b2 + kstepB;
            if (last && has_next) S.a_ready(nxt);
            if constexpr (SP2) {
            PG8_LDB(B0, 0, 0); PG8_LDB(B1, 0, 1); PG8_SCHED; PG8_LDA(At, 0, 0); PG8_STAGE(PG8_SA(1, 1), a1 + hstepA, voffA);
            PG8_WAIT_V(8); PG8_WAIT_L(0); PG8_BAR; PG8_MMA(0, 0, At, B0); PG8_MMA(0, 1, At, B1); PG8_BAR; PG8_SCHED;
            PG8_LDA(At, 0, 1); PG8_STAGE(PG8_SB(0, 0), b2, voffB); PG8_STAGE(PG8_SB(0, 1), b2 + hstepB, voffB); PG8_STAGE(PG8_SA(0, 0), a2, voffA);
            PG8_WAIT_V(8); PG8_WAIT_L(0); PG8_BAR; PG8_MMA(1, 0, At, B0); PG8_MMA(1, 1, At, B1); PG8_BAR; PG8_SCHED;
            PG8_LDB(B0, 1, 0); PG8_LDB(B1, 1, 1); PG8_SCHED; PG8_LDA(At, 1, 0); PG8_STAGE(PG8_SA(0, 1), a2 + hstepA, voffA);
            PG8_WAIT_V(8); PG8_WAIT_L(0); PG8_BAR; PG8_MMA(0, 0, At, B0); PG8_MMA(0, 1, At, B1); PG8_BAR; PG8_SCHED;
            PG8_LDA(At, 1, 1); PG8_STAGE(PG8_SB(1, 0), b3, voffB); PG8_STAGE(PG8_SB(1, 1), b3 + hstepB, voffB); PG8_STAGE(PG8_SA(1, 0), a3, voffA);
            PG8_WAIT_V(8); PG8_WAIT_L(0); PG8_BAR; PG8_MMA(1, 0, At, B0); PG8_MMA(1, 1, At, B1); PG8_BAR; PG8_SCHED;
            } else {
            PG8_LDB(B0, 0, 0); PG8_SCHED; PG8_LDA(At, 0, 0); PG8_STAGE(PG8_SA(1, 1), a1 + hstepA, voffA);
            PG8_WAIT_L(8); PG8_BAR; PG8_WAIT_L(0); PG8_MMA(0, 0, At, B0); PG8_BAR; PG8_SCHED;
            PG8_LDB(B1, 0, 1); PG8_STAGE(PG8_SB(0, 0), b2, voffB);
            PG8_BAR; PG8_WAIT_L(0); PG8_MMA(0, 1, At, B1); PG8_BAR;
            PG8_LDA(At, 0, 1); PG8_STAGE(PG8_SA(0, 0), a2, voffA);
            PG8_BAR; PG8_WAIT_L(0); PG8_MMA(1, 0, At, B0); PG8_BAR; PG8_SCHED;
            PG8_STAGE(PG8_SB(0, 1), b2 + hstepB, voffB);
            PG8_WAIT_V(6); PG8_BAR; PG8_MMA(1, 1, At, B1); PG8_BAR;
            PG8_LDB(B0, 1, 0); PG8_SCHED; PG8_LDA(At, 1, 0); PG8_STAGE(PG8_SA(0, 1), a2 + hstepA, voffA);
            PG8_WAIT_L(8); PG8_BAR; PG8_WAIT_L(0); PG8_MMA(0, 0, At, B0); PG8_BAR; PG8_SCHED;
            PG8_LDB(B1, 1, 1); PG8_STAGE(PG8_SB(1, 0), b3, voffB);
            PG8_BAR; PG8_WAIT_L(0); PG8_MMA(0, 1, At, B1); PG8_BAR;
            PG8_LDA(At, 1, 1); PG8_STAGE(PG8_SA(1, 0), a3, voffA);
            PG8_BAR; PG8_WAIT_L(0); PG8_MMA(1, 0, At, B0); PG8_BAR; PG8_SCHED;
            PG8_STAGE(PG8_SB(1, 1), b3 + hstepB, voffB);
            PG8_WAIT_V(6); PG8_BAR; PG8_MMA(1, 1, At, B1); PG8_BAR;
            }
        }
        if constexpr (Epi::HAS_PRE) {
            typename Epi::Pre pre; E.preload(pre, cur, wr, wc, fr, fq);
            if constexpr (ALIGN_EPI) { if (wr == 0) PG8_BAR; }
            E(acc, cur, wr, wc, fr, fq, (ssq_lds_t)(lds + SSQ_LDS_OFF + (ui & 1) * 2048), pre); S.done(cur);
        } else {
            if constexpr (ALIGN_EPI) { if (wr == 0) PG8_BAR; }
            if constexpr (!Epi::AFTER_DRAIN) { E(acc, cur, wr, wc, fr, fq, (ssq_lds_t)(lds + SSQ_LDS_OFF + (ui & 1) * 2048)); S.done(cur); }
        }
        if (!has_next) break;
#pragma unroll
        for (int a = 0; a < 2; ++a)
#pragma unroll
            for (int b = 0; b < 2; ++b)
#pragma unroll
                for (int m = 0; m < 4; ++m)
#pragma unroll
                    for (int n = 0; n < 2; ++n) { f64x2_t z; asm volatile("v_mov_b64 %0, 0" : "=v"(z.x)); asm volatile("v_mov_b64 %0, 0" : "=v"(z.y)); acc[a][b][m][n] = __builtin_bit_cast(f32x4, z); }
        cur = nxt; cA = nA; cB = nB; ++ui;
        if constexpr (ALIGN_EPI) { if (wr == 1) PG8_BAR; }
    }
    PG8_WAIT_V(0);
    if constexpr (!ALIGN_EPI) { if (wr == 0) PG8_BAR; }
    PG8_BAR;
#undef PG8_SA
#undef PG8_SB
#undef PG8_STAGE
#undef PG8_LDA
#undef PG8_LDB
#undef PG8_MMA
#undef PG8_WAIT_V
#undef PG8_WAIT_L
#undef PG8_BAR
#undef PG8_SCHED
}
}

constexpr int NWAVES = 8;
constexpr int BATCH = 2, SEQ = 16384, D = 2048, DEPTH = 2, FF = 5632;
constexpr int M = BATCH * SEQ;
constexpr int AW = 1536, AOW = 512;
constexpr int RQK = 2048, RV = 4096;
constexpr int INC = 20992;
constexpr float RMS_EPS = 1e-6f, GN_EPS = 1e-5f;
constexpr float LOG2E = 1.44269504089f;

constexpr size_t MiB = 1u << 20;
constexpr size_t WS_CTL = 0, CTL_ZERO_BYTES = 1 * MiB;
constexpr size_t WS_COSA = 1 * MiB, WS_SINA = 5 * MiB, WS_COSR = 9 * MiB, WS_SINR = 17 * MiB;
constexpr size_t WS_SSQ = 29 * MiB, SSQ_BYTES = (size_t)32768 * 8;
constexpr size_t WS_MLM = 25 * MiB, WS_MLL = 27 * MiB, WS_GST = 25 * MiB;
constexpr size_t WS_WGU1 = 32 * MiB, WS_WD1 = 76 * MiB, WS_WIN = 98 * MiB, WS_WPA = 180 * MiB, WS_WPR = 182 * MiB, WS_WOUT = 198 * MiB, WS_WGU2 = 206 * MiB, WS_WD2 = 250 * MiB;
constexpr size_t GST_BYTES = (size_t)32768 * 8 * 2 * 8;
constexpr size_t WS_H = 272 * MiB;
constexpr size_t WS_R = 400 * MiB;
constexpr size_t WS_HID = WS_R;
constexpr size_t WS_QA = WS_R, WS_KA = WS_R + 96 * MiB, WS_VA = WS_R + 192 * MiB, WS_OG = 1184 * MiB;
constexpr size_t WS_QR = WS_R, WS_KR = WS_R + 128 * MiB, WS_VR = WS_R + 256 * MiB, WS_OR = WS_R + 512 * MiB;
constexpr size_t WS_PR = WS_R + 768 * MiB;
constexpr size_t WS_SGA = WS_R, WS_SGB = WS_R + 128 * MiB;
constexpr size_t WS_OA = 1280 * MiB;
constexpr size_t WS_END = 1312 * MiB;
static_assert(WS_PR == WS_OR + 256 * MiB && WS_PR + 64 * MiB <= WS_OA && WS_VA - WS_KA == WS_KA - WS_QA && WS_OR + 256 * MiB <= WS_OA && WS_OG + 96 * MiB <= WS_OA && WS_OG >= WS_OR + 256 * MiB && WS_HID + 352 * MiB <= WS_OA, "ws map");
constexpr int CW_TMO = 0;
constexpr int CW_BAR = 4096;

constexpr int RING_BYTES = 131072;
constexpr int LDSCTL_OFF = 143360, MISC_OFF = LDSCTL_OFF + 320;
constexpr int LDS_BYTES = 147456;

#define GAS __attribute__((address_space(1)))
#define LAS __attribute__((address_space(3)))
typedef unsigned short bf16;
typedef unsigned v4u __attribute__((ext_vector_type(4)));
typedef unsigned v2u __attribute__((ext_vector_type(2)));
typedef float f32x4 __attribute__((ext_vector_type(4)));
typedef short bf16x8 __attribute__((ext_vector_type(8)));
typedef GAS unsigned gu32;
#define RLX_AGENT __ATOMIC_RELAXED, __HIP_MEMORY_SCOPE_AGENT
#define LDS_WAIT() asm volatile("s_waitcnt lgkmcnt(0)" ::: "memory")
#define VM_WAIT() asm volatile("s_waitcnt vmcnt(0)" ::: "memory")
__device__ __forceinline__ unsigned f2bf(float f) { unsigned u = __builtin_bit_cast(unsigned, f); return (u + 0x7fffu + ((u >> 16) & 1u)) >> 16; }
__device__ __forceinline__ unsigned pk2(float lo, float hi) { return f2bf(lo) | (f2bf(hi) << 16); }
__device__ __forceinline__ float bf_lo(unsigned w) { return __uint_as_float(w << 16); }
__device__ __forceinline__ float bf_hi(unsigned w) { return __uint_as_float(w & 0xffff0000u); }

#define XB_TMO      128
#define XB_XCNT(j)  (256  + 64 * (j))
#define XB_XSUB(j)  (1280 + 64 * (j))
#define XB_XGEN(j)  (2304 + 64 * (j))
#define XB_TOP      3328
#define XB_TOPGEN   3392
#define XCD_BAR_WORDS 3456
#define XB_SPIN_CAP (1u << 18)

__device__ __forceinline__ unsigned xb_ld(unsigned* p)              { return __hip_atomic_load(p, __ATOMIC_RELAXED, __HIP_MEMORY_SCOPE_AGENT); }
__device__ __forceinline__ unsigned xb_add(unsigned* p, unsigned v) { return __hip_atomic_fetch_add(p, v, __ATOMIC_RELAXED, __HIP_MEMORY_SCOPE_AGENT); }
__device__ __forceinline__ unsigned xb_xcc_id() { return (unsigned)__builtin_amdgcn_s_getreg((3 << 11) | 20) & 0xFu; }
#define XB_SPIN(cond, bar) do { unsigned _sp = 0; while (cond) { __builtin_amdgcn_s_sleep(1); \
    if ((++_sp & 255u) == 0u) { if (xb_ld(&(bar)[XB_TMO])) break; if (_sp > XB_SPIN_CAP) { atomicAdd(&(bar)[XB_TMO], 1u); break; } } } } while (0)

struct XcdBarrier {
    unsigned* bar; unsigned x;
    volatile LAS unsigned* st;
};
__device__ __forceinline__ XcdBarrier xcd_barrier_post(unsigned* bar, volatile LAS unsigned* st) {
    XcdBarrier b; b.bar = bar; b.x = xb_xcc_id(); b.st = st;
    if (threadIdx.x == 0) (void)xb_add(&bar[XB_XCNT(b.x)], 1u);
    return b;
}
__device__ __forceinline__ void xcd_barrier_complete(unsigned* bar, unsigned x, unsigned& nloc, unsigned& nx) {
    const unsigned G = gridDim.x * gridDim.y * gridDim.z;
    unsigned sum, cnt, mine, sp = 0u;
    for (;;) {
        sum = 0u; cnt = 0u; mine = 0u;
#pragma unroll
        for (unsigned j = 0; j < 16; ++j) { const unsigned c = xb_ld(&bar[XB_XCNT(j)]); sum += c; cnt += (c > 0u) ? 1u : 0u; mine = (j == x) ? c : mine; }
        if (sum == G) break;
        __builtin_amdgcn_s_sleep(1);
        if ((++sp & 255u) == 0u) { if (xb_ld(&bar[XB_TMO])) break; if (sp > XB_SPIN_CAP) { atomicAdd(&bar[XB_TMO], 1u); break; } }
    }
    nloc = mine > 0u ? mine : 1u; nx = cnt > 0u ? cnt : 1u;
}
__device__ __forceinline__ void xcd_barrier(const XcdBarrier& b) {
    asm volatile("s_waitcnt vmcnt(0)" ::: "memory");
    __syncthreads();
    if (threadIdx.x == 0) {
        unsigned* bar = b.bar;
        __builtin_amdgcn_s_waitcnt(0);
        unsigned nloc = b.st[0], nx = b.st[1];
        if (nloc == 0u) { xcd_barrier_complete(bar, b.x, nloc, nx); b.st[0] = nloc; b.st[1] = nx; }
        const unsigned old = xb_add(&bar[XB_XSUB(b.x)], 1u);
        const unsigned gen = old / nloc;
        if (old + 1u == (gen + 1u) * nloc) {
            __builtin_amdgcn_fence(__ATOMIC_RELEASE, "agent");
            asm volatile("s_waitcnt vmcnt(0)" ::: "memory");
            const unsigned og = xb_add(&bar[XB_TOP], 1u);
            const unsigned tg = og / nx;
            if (og + 1u == (tg + 1u) * nx) xb_add(&bar[XB_TOPGEN], 1u);
            else XB_SPIN(xb_ld(&bar[XB_TOPGEN]) == tg, bar);
            __builtin_amdgcn_fence(__ATOMIC_ACQUIRE, "agent");
            xb_add(&bar[XB_XGEN(b.x)], 1u);
            asm volatile("s_waitcnt vmcnt(0)" ::: "memory");
        } else {
            XB_SPIN(xb_ld(&bar[XB_XGEN(b.x)]) == gen, bar);
            __builtin_amdgcn_fence(__ATOMIC_ACQUIRE, "agent");
            asm volatile("s_waitcnt vmcnt(0)" ::: "memory");
        }
    }
    __syncthreads();
}

struct Frame {
    LAS unsigned char* lds;
    int tid, lane, wave;
    int vcu, G, bx;
    unsigned char* ws;
};
template <int CTRL> __device__ __forceinline__ float dpp_get(float v) { return __builtin_bit_cast(float, __builtin_amdgcn_update_dpp(0, __builtin_bit_cast(int, v), CTRL, 0xf, 0xf, true)); }
__device__ __forceinline__ float wave_sum(float v) {
    v += dpp_get<0xB1>(v); v += dpp_get<0x4E>(v); v += dpp_get<0x141>(v); v += dpp_get<0x140>(v);
    return pg8::xor32_sum(pg8::xor16_sum(v));
}

struct ConvItem { const float* W; const float* gn; bf16* WT; int K, Nsrc, dst_row0, k0, srccol; };
__device__ __forceinline__ void conv_load(const ConvItem& I, int lane, float (&wv)[32], f32x4& g0, f32x4& g1) {
#pragma unroll
    for (int i = 0; i < 32; ++i) wv[i] = I.W[(size_t)(I.k0 + 2 * i + (lane >> 5)) * I.Nsrc + I.srccol];
    g0 = (f32x4){1.f, 1.f, 1.f, 1.f}; g1 = g0;
    if (I.gn) { g0 = *(const f32x4*)(I.gn + I.k0 + 8 * (lane & 7)); g1 = *(const f32x4*)(I.gn + I.k0 + 8 * (lane & 7) + 4); }
}
__device__ __forceinline__ void conv_to_lds(const float (&wv)[32], LAS float* scr, int lane) {
#pragma unroll
    for (int i = 0; i < 32; ++i) scr[(2 * i + (lane >> 5)) * 33 + (lane & 31)] = wv[i];
    LDS_WAIT(); asm volatile("" ::: "memory");
}
__device__ __forceinline__ void conv_store(const ConvItem& I, const LAS float* scr, int lane, f32x4 g0, f32x4 g1) {
    const int c = lane & 7;
#pragma unroll
    for (int j = 0; j < 4; ++j) { const int n = (lane >> 3) + 8 * j; const LAS float* s = scr + (8 * c) * 33 + n;
        v4u o; o.x = pk2(s[0 * 33] * g0.x, s[1 * 33] * g0.y); o.y = pk2(s[2 * 33] * g0.z, s[3 * 33] * g0.w); o.z = pk2(s[4 * 33] * g1.x, s[5 * 33] * g1.y); o.w = pk2(s[6 * 33] * g1.z, s[7 * 33] * g1.w);
        const int row = I.dst_row0 + n;
        *(GAS v4u*)(I.WT + (((size_t)(row >> 8) * (I.K >> 6) + (I.k0 >> 6)) * 256 + (row & 255)) * 64 + 8 * c) = o; }
    LDS_WAIT(); asm volatile("" ::: "memory");
}
__device__ __forceinline__ int win_src_col(int r) {
    if (r < 3072) { const int sec = r / 1536, rr = r - sec * 1536, head = rr >> 7, p = rr & 127; const int wc = p >> 5, fq = (p >> 3) & 3, n = (p >> 2) & 1, j = p & 3; const int i = wc * 16 + fq * 4 + j; return sec * 1536 + head * 128 + n * 64 + i; }
    if (r < 4608) return r;
    if (r < 8704) { int rr = r - 4608; const int sec = rr >> 11; rr &= 2047; const int head = rr >> 8, p = rr & 255; const int bj = p >> 7, wc = (p >> 5) & 3, fq = (p >> 3) & 3, n = (p >> 2) & 1, j = p & 3; const int i = bj * 64 + wc * 16 + fq * 4 + j; return 4608 + sec * 2048 + head * 256 + n * 128 + i; }
    return r;
}
struct LayerW { const float *g1, *u1, *d1, *win, *pa, *pr, *wo, *g2, *u2, *d2, *n1, *nm, *n2; };
__device__ __forceinline__ ConvItem conv_decode(const Frame& F, const LayerW& L, int it) {
    constexpr int I_GU = (D / 64) * (FF / 32), I_D = (FF / 64) * (D / 32), I_IN = (D / 64) * (INC / 32), I_PA = (AOW / 64) * (D / 32), I_PR = (RV / 64) * (D / 32), I_WO = (D / 64) * (D / 32);
    int r = it; const float* W; const float* gn = nullptr; int K, Nsrc, nblk, mode; bf16* WT;
    if (r < I_GU) { W = L.g1; gn = L.n1; K = D; Nsrc = FF; nblk = FF / 32; mode = 1; WT = (bf16*)(F.ws + WS_WGU1); }
    else if ((r -= I_GU) < I_GU) { W = L.u1; gn = L.n1; K = D; Nsrc = FF; nblk = FF / 32; mode = 2; WT = (bf16*)(F.ws + WS_WGU1); }
    else if ((r -= I_GU) < I_D) { W = L.d1; K = FF; Nsrc = D; nblk = D / 32; mode = 0; WT = (bf16*)(F.ws + WS_WD1); }
    else if ((r -= I_D) < I_IN) { W = L.win; gn = L.nm; K = D; Nsrc = INC; nblk = INC / 32; mode = 3; WT = (bf16*)(F.ws + WS_WIN); }
    else if ((r -= I_IN) < I_PA) { W = L.pa; K = AOW; Nsrc = D; nblk = D / 32; mode = 0; WT = (bf16*)(F.ws + WS_WPA); }
    else if ((r -= I_PA) < I_PR) { W = L.pr; K = RV; Nsrc = D; nblk = D / 32; mode = 0; WT = (bf16*)(F.ws + WS_WPR); }
    else if ((r -= I_PR) < I_WO) { W = L.wo; K = D; Nsrc = D; nblk = D / 32; mode = 0; WT = (bf16*)(F.ws + WS_WOUT); }
    else if ((r -= I_WO) < I_GU) { W = L.g2; gn = L.n2; K = D; Nsrc = FF; nblk = FF / 32; mode = 1; WT = (bf16*)(F.ws + WS_WGU2); }
    else if ((r -= I_GU) < I_GU) { W = L.u2; gn = L.n2; K = D; Nsrc = FF; nblk = FF / 32; mode = 2; WT = (bf16*)(F.ws + WS_WGU2); }
    else { r -= I_GU; W = L.d2; K = FF; Nsrc = D; nblk = D / 32; mode = 0; WT = (bf16*)(F.ws + WS_WD2); }
    const int kb = r / nblk, nb = r - kb * nblk;
    int dst_row0 = 32 * nb, srccol = 32 * nb + (F.lane & 31);
    if (mode == 1 || mode == 2) dst_row0 = 256 * (nb >> 2) + 32 * (nb & 3) + (mode == 2 ? 128 : 0);
    if (mode == 3) srccol = win_src_col(32 * nb + (F.lane & 31));
    ConvItem I{W, gn, WT, K, Nsrc, dst_row0, 64 * kb, srccol};
    return I;
}
__device__ __forceinline__ void convert_weights(Frame& F, const LayerW& L) {
    LAS float* scr = (LAS float*)(F.lds + F.wave * 16384);
    const int gw = F.vcu * NWAVES + F.wave, NGW = F.G * NWAVES;
    constexpr int I_GU = (D / 64) * (FF / 32), I_D = (FF / 64) * (D / 32), I_IN = (D / 64) * (INC / 32), I_PA = (AOW / 64) * (D / 32), I_PR = (RV / 64) * (D / 32), I_WO = (D / 64) * (D / 32);
    constexpr int NIT = 4 * I_GU + 2 * I_D + I_IN + I_PA + I_PR + I_WO;
    if (gw >= NIT) return;
    float wv[32]; f32x4 g0, g1;
    ConvItem cur = conv_decode(F, L, gw);
    conv_load(cur, F.lane, wv, g0, g1);
    for (int it = gw; it < NIT; it += NGW) {
        const bool has_next = it + NGW < NIT;
        const ConvItem nxt = conv_decode(F, L, has_next ? it + NGW : it);
        conv_to_lds(wv, scr, F.lane);
        const f32x4 c0 = g0, c1 = g1;
        if (has_next) conv_load(nxt, F.lane, wv, g0, g1);
        conv_store(cur, scr, F.lane, c0, c1);
        cur = nxt;
    }
}
__device__ __forceinline__ void sincos_f32arg(float ang, float& s_out, float& c_out) {
    const double x = (double)ang;
    const double kd = __builtin_rint(x * 0.63661977236758134308);
    double r = __builtin_fma(-kd, 1.57079632679489655800e+00, x);
    r = __builtin_fma(-kd, 6.12323399573676603587e-17, r);
    const double r2 = r * r;
    double sp = 1.0 / 6227020800.0; sp = sp * r2 - 1.0 / 39916800.0; sp = sp * r2 + 1.0 / 362880.0; sp = sp * r2 - 1.0 / 5040.0; sp = sp * r2 + 1.0 / 120.0; sp = sp * r2 - 1.0 / 6.0; sp = sp * r2 * r + r;
    double cp = -1.0 / 87178291200.0; cp = cp * r2 + 1.0 / 479001600.0; cp = cp * r2 - 1.0 / 3628800.0; cp = cp * r2 + 1.0 / 40320.0; cp = cp * r2 - 1.0 / 720.0; cp = cp * r2 + 1.0 / 24.0; cp = cp * r2 - 0.5; cp = cp * r2 + 1.0;
    const int q = ((int)kd) & 3;
    const double sv = (q == 0) ? sp : (q == 1) ? cp : (q == 2) ? -sp : -cp;
    const double cv = (q == 0) ? cp : (q == 1) ? -sp : (q == 2) ? -cp : sp;
    s_out = (float)sv; c_out = (float)cv;
}
__device__ __forceinline__ void rope_tables(Frame& F) {
    float* cosa = (float*)(F.ws + WS_COSA); float* sina = (float*)(F.ws + WS_SINA); float* cosr = (float*)(F.ws + WS_COSR); float* sinr = (float*)(F.ws + WS_SINR);
    const int gt = F.vcu * (NWAVES * 64) + F.tid, NT = F.G * NWAVES * 64;
    const bool fixed_i = (NT & 127) == 0;
    float inv0 = 0.f;
    if (fixed_i) { const float ex0 = (float)(2 * (gt & 127)) / 256.0f; inv0 = 1.0f / (float)exp2((double)ex0 * 13.287712379549449); }
    for (int idx = gt; idx < SEQ * 128; idx += NT) {
        const int t = idx >> 7, i = idx & 127;
        float inv = inv0;
        if (!fixed_i) { const float ex = (float)(2 * i) / 256.0f; inv = 1.0f / (float)exp2((double)ex * 13.287712379549449); }
        const float ang = (float)t * inv;
        float s, c; sincos_f32arg(ang, s, c);
        cosr[idx] = c; sinr[idx] = s;
        if ((i & 1) == 0) { cosa[t * 64 + (i >> 1)] = c; sina[t * 64 + (i >> 1)] = s; }
    }
}
__device__ __forceinline__ void stream_rows_input(Frame& F, const float* x, bf16* XB, unsigned long long* ssq) {
    const int gw = F.vcu * NWAVES + F.wave, NGW = F.G * NWAVES;
    for (int m = gw; m < M; m += NGW) {
        const f32x4* xr = (const f32x4*)(x + (size_t)m * D) + 2 * F.lane;
        f32x4 v[8]; float s = 0.f;
#pragma unroll
        for (int j = 0; j < 4; ++j) { v[2 * j] = xr[128 * j]; v[2 * j + 1] = xr[128 * j + 1]; }
#pragma unroll
        for (int j = 0; j < 8; ++j) s += (v[j].x * v[j].x + v[j].y * v[j].y) + (v[j].z * v[j].z + v[j].w * v[j].w);
        s = wave_sum(s);
        v4u* x16 = (v4u*)(XB + (size_t)m * D) + F.lane;
#pragma unroll
        for (int j = 0; j < 4; ++j) {
            const f32x4 a = v[2 * j], b = v[2 * j + 1];
            v4u c; c.x = pk2(a.x, a.y); c.y = pk2(a.z, a.w); c.z = pk2(b.x, b.y); c.w = pk2(b.z, b.w);
            x16[64 * j] = c;
        }
        if (F.lane == 0) ssq[m] = (unsigned long long)(s * pg8::SSQ_FIX);
    }
}
__device__ __forceinline__ void norm_rows_final(Frame& F, const bf16* x, const float* gain, float* out) {
    const int gw = F.vcu * NWAVES + F.wave, NGW = F.G * NWAVES;
    f32x4 gv[8];
#pragma unroll
    for (int j = 0; j < 4; ++j) { gv[2 * j] = *((const f32x4*)gain + 2 * (F.lane + 64 * j)); gv[2 * j + 1] = *((const f32x4*)gain + 2 * (F.lane + 64 * j) + 1); }
    for (int m = gw; m < M; m += NGW) {
        const v4u* xr = (const v4u*)(x + (size_t)m * D) + F.lane;
        v4u r[4]; float s = 0.f;
#pragma unroll
        for (int j = 0; j < 4; ++j) r[j] = xr[64 * j];
        f32x4 v[8];
#pragma unroll
        for (int j = 0; j < 4; ++j) { v[2 * j] = (f32x4){bf_lo(r[j].x), bf_hi(r[j].x), bf_lo(r[j].y), bf_hi(r[j].y)}; v[2 * j + 1] = (f32x4){bf_lo(r[j].z), bf_hi(r[j].z), bf_lo(r[j].w), bf_hi(r[j].w)}; }
#pragma unroll
        for (int j = 0; j < 8; ++j) s += (v[j].x * v[j].x + v[j].y * v[j].y) + (v[j].z * v[j].z + v[j].w * v[j].w);
        const float rstd = 1.0f / sqrtf(wave_sum(s) * (1.0f / D) + RMS_EPS);
        f32x4* o = (f32x4*)(out + (size_t)m * D) + 2 * F.lane;
#pragma unroll
        for (int j = 0; j < 4; ++j) { o[128 * j] = v[2 * j] * rstd * gv[2 * j]; o[128 * j + 1] = v[2 * j + 1] * rstd * gv[2 * j + 1]; }
    }
}

#define RAW_BARRIER() do { asm volatile("s_waitcnt lgkmcnt(0)" ::: "memory"); __builtin_amdgcn_s_barrier(); asm volatile("" ::: "memory"); } while (0)
typedef short v4i16_t __attribute__((ext_vector_type(4)));
__device__ __forceinline__ v4i16_t lds_tr(const LAS unsigned char* p) { return __builtin_amdgcn_ds_read_tr16_b64_v4i16((LAS v4i16_t*)p); }
__device__ __forceinline__ bf16x8 cat8(v4i16_t lo, v4i16_t hi) { return __builtin_shufflevector(lo, hi, 0, 1, 2, 3, 4, 5, 6, 7); }

constexpr int ATT_KROW = 272, ATT_VROW = 288;
constexpr int ATT_KOFF = 0, ATT_VOFF = 256 * ATT_KROW;
static_assert(ATT_VOFF + 256 * ATT_VROW <= LDSCTL_OFF, "attention LDS map");
__device__ __forceinline__ void attn_phase(Frame& F) {
    const bf16* QA = (const bf16*)(F.ws + WS_QA); const bf16* KA = (const bf16*)(F.ws + WS_KA); const bf16* VA = (const bf16*)(F.ws + WS_VA);
    bf16* OG = (bf16*)(F.ws + WS_OG); float* MLM = (float*)(F.ws + WS_MLM); float* MLL = (float*)(F.ws + WS_MLL);
    LAS unsigned char* Kl = F.lds + ATT_KOFF; LAS unsigned char* Vl = F.lds + ATT_VOFF;
    const int w = F.wave, lane = F.lane, r16 = lane & 15, g4 = lane >> 4;
#define ATT_DECODE(u_, b_, g_, hg_, d_, r_, n_, hh_) \
        const int b_ = (u_) / 1536; int rem_##b_ = (u_) - b_ * 1536; const int g_ = rem_##b_ >> 9; rem_##b_ &= 511; const int hg_ = rem_##b_ >> 7; const int blk_##b_ = rem_##b_ & 127; \
        const int dl_##b_ = 2 * g_, d_ = 1 << dl_##b_; const int nb_##b_ = 128 >> dl_##b_; const int r_ = blk_##b_ / nb_##b_, n_ = blk_##b_ - r_ * nb_##b_; const int hh_ = g_ * 4 + hg_;
#define ATT_REQUEST(u_) do { ATT_DECODE(u_, pb_, pg_, phg_, pd_, pr_, pn_, phh_) \
        _Pragma("unroll") for (int c = 0; c < 8; ++c) { const int idx = F.tid + 512 * c, kj = idx >> 4, ch = idx & 15; \
            kreg[c] = (v4u){0u, 0u, 0u, 0u}; vreg[c] = (v4u){0u, 0u, 0u, 0u}; \
            if ((pn_ > 0) || (kj >= 128)) { const int pos = ((pn_ - 1) * 128 + kj) * pd_ + pr_; const size_t off = (size_t)(pb_ * SEQ + pos) * AW + phh_ * 128 + ch * 8; kreg[c] = *(const v4u*)(KA + off); vreg[c] = *(const v4u*)(VA + off); } } \
        { const int pos = (pn_ * 128 + 16 * w + r16) * pd_ + pr_; const bf16* qp = QA + (size_t)(pb_ * SEQ + pos) * AW + phh_ * 128 + 8 * g4; \
          _Pragma("unroll") for (int ks = 0; ks < 4; ++ks) qn[ks] = *(const bf16x8*)(qp + 32 * ks); } } while (0)
#define ATT_REQUEST_OWN(u_) do { ATT_DECODE(u_, pb_, pg_, phg_, pd_, pr_, pn_, phh_) \
        _Pragma("unroll") for (int c = 0; c < 4; ++c) { const int idx = F.tid + 512 * c, kj = idx >> 4, ch = idx & 15; \
            const int pos = (pn_ * 128 + kj) * pd_ + pr_; const size_t off = (size_t)(pb_ * SEQ + pos) * AW + phh_ * 128 + ch * 8; kreg[c] = *(const v4u*)(KA + off); vreg[c] = *(const v4u*)(VA + off); } \
        { const int pos = (pn_ * 128 + 16 * w + r16) * pd_ + pr_; const bf16* qp = QA + (size_t)(pb_ * SEQ + pos) * AW + phh_ * 128 + 8 * g4; \
          _Pragma("unroll") for (int ks = 0; ks < 4; ++ks) qn[ks] = *(const bf16x8*)(qp + 32 * ks); } } while (0)
    v4u kreg[8], vreg[8]; bf16x8 qn[4];
    const bool seqmap = (3072 % F.G) == 0;
    const int nunits = seqmap ? 3072 / F.G : (F.vcu < 3072 ? (3072 - F.vcu + F.G - 1) / F.G : 0);
#define ATT_UNIT(k_) (seqmap ? F.vcu * nunits + (k_) : F.vcu + (k_) * F.G)
    if (nunits > 0) ATT_REQUEST(ATT_UNIT(0));
    int oh = 1; bool own_only = false;
    for (int k = 0; k < nunits; ++k) {
        const int u = ATT_UNIT(k);
        ATT_DECODE(u, b, g, hg, d, r, n, hh)
        (void)hh;
        if (!own_only) {
            oh = 1;
#pragma unroll
            for (int c = 0; c < 8; ++c) { const int idx = F.tid + 512 * c, kj = idx >> 4, ch = idx & 15; *(LAS v4u*)(Kl + kj * ATT_KROW + ch * 16) = kreg[c]; *(LAS v4u*)(Vl + kj * ATT_VROW + ch * 16) = vreg[c]; }
        } else {
            oh ^= 1;
#pragma unroll
            for (int c = 0; c < 4; ++c) { const int idx = F.tid + 512 * c, kj = oh * 128 + (idx >> 4), ch = idx & 15; *(LAS v4u*)(Kl + kj * ATT_KROW + ch * 16) = kreg[c]; *(LAS v4u*)(Vl + kj * ATT_VROW + ch * 16) = vreg[c]; }
        }
        bf16x8 qf[4];
#pragma unroll
        for (int ks = 0; ks < 4; ++ks) qf[ks] = qn[ks];
        bool next_own = false;
        if (k + 1 < nunits) {
            const int un = ATT_UNIT(k + 1);
            { ATT_DECODE(un, zb, zg, zhg, zd, zr, zn, zhh) (void)zb; (void)zhg; (void)zd; (void)zr; (void)zhh; next_own = seqmap && (zn > 0); }
            if (next_own) ATT_REQUEST_OWN(un); else ATT_REQUEST(un);
        }
        RAW_BARRIER();
        const int x8 = (oh ^ 1) << 3;
        f32x4 s[9];
#pragma unroll
        for (int t = 0; t < 9; ++t) {
            s[t] = (f32x4){0.f, 0.f, 0.f, 0.f};
            const LAS unsigned char* kp = Kl + (16 * ((w + t) ^ x8) + r16) * ATT_KROW + 16 * g4;
#pragma unroll
            for (int ks = 0; ks < 4; ++ks) { const bf16x8 a = *(const LAS bf16x8*)(kp + 64 * ks); s[t] = __builtin_amdgcn_mfma_f32_16x16x32_bf16(a, qf[ks], s[t], 0, 0, 0); }
        }
        const int qi = 16 * w + r16;
        float mx = -1e30f;
#pragma unroll
        for (int t = 0; t < 9; ++t)
#pragma unroll
            for (int q = 0; q < 4; ++q) { const int kj = 16 * (w + t) + 4 * g4 + q; const bool valid = (kj >= qi) && (kj <= qi + 128) && ((n > 0) || (kj >= 128)); s[t][q] = valid ? s[t][q] : -1e30f; mx = fmaxf(mx, s[t][q]); }
        mx = pg8::xor32_max(pg8::xor16_max(mx));
        float ls = 0.f;
#pragma unroll
        for (int t = 0; t < 9; ++t)
#pragma unroll
            for (int q = 0; q < 4; ++q) { const float p = (s[t][q] > -1e29f) ? __builtin_amdgcn_exp2f((s[t][q] - mx) * LOG2E) : 0.f; s[t][q] = p; ls += p; }
        ls = pg8::xor32_sum(pg8::xor16_sum(ls));
        bf16x8 pa[5];
#pragma unroll
        for (int st = 0; st < 5; ++st) {
            v4u pw;
            pw.x = pg8::cvt_pk_bf16(s[2 * st][0], s[2 * st][1]); pw.y = pg8::cvt_pk_bf16(s[2 * st][2], s[2 * st][3]);
            if (2 * st + 1 < 9) { pw.z = pg8::cvt_pk_bf16(s[2 * st + 1][0], s[2 * st + 1][1]); pw.w = pg8::cvt_pk_bf16(s[2 * st + 1][2], s[2 * st + 1][3]); } else { pw.z = 0u; pw.w = 0u; }
            pa[st] = __builtin_bit_cast(bf16x8, pw);
        }
        const LAS unsigned char* vtr = Vl + (4 * g4 + (r16 >> 2)) * ATT_VROW + (4 * (r16 & 3)) * 2;
        f32x4 o[8];
#pragma unroll
        for (int et = 0; et < 8; ++et) {
            o[et] = (f32x4){0.f, 0.f, 0.f, 0.f};
#pragma unroll
            for (int st = 0; st < 5; ++st) {
                const v4i16_t vlo = lds_tr(vtr + (16 * ((w + 2 * st) ^ x8)) * ATT_VROW + 32 * et);
                v4i16_t vhi = (v4i16_t){0, 0, 0, 0};
                if (2 * st + 1 < 9) vhi = lds_tr(vtr + (16 * ((w + 2 * st + 1) ^ x8)) * ATT_VROW + 32 * et);
                const bf16x8 vb = cat8(vlo, vhi);
                o[et] = __builtin_amdgcn_mfma_f32_16x16x32_bf16(vb, pa[st], o[et], 0, 0, 0);
            }
        }
        {
            const float linv = 1.0f / ls;
            const int pos = (n * 128 + qi) * d + r;
            bf16* op = OG + ((size_t)g * M + (size_t)(b * SEQ + pos)) * AOW + hg * 128 + 4 * g4;
#pragma unroll
            for (int et = 0; et < 8; ++et) { v2u w; w.x = pg8::cvt_pk_bf16(o[et][0] * linv, o[et][1] * linv); w.y = pg8::cvt_pk_bf16(o[et][2] * linv, o[et][3] * linv); *(v2u*)(op + 16 * et) = w; }
        }
        if (g4 == 0) {
            const int pos = (n * 128 + qi) * d + r;
            const size_t mi = ((size_t)g * M + (size_t)(b * SEQ + pos)) * 4 + hg;
            MLM[mi] = mx; MLL[mi] = ls;
        }
        RAW_BARRIER();
        own_only = next_own;
    }
}
__device__ __forceinline__ void attn_merge_rows(Frame& F) {
    const bf16* OG = (const bf16*)(F.ws + WS_OG); const float* MLM = (const float*)(F.ws + WS_MLM); const float* MLL = (const float*)(F.ws + WS_MLL);
    bf16* OA = (bf16*)(F.ws + WS_OA);
    const int gw = F.vcu * NWAVES + F.wave, NGW = F.G * NWAVES;
    const int hg = F.lane >> 4;
    for (int m0 = gw; m0 < M; m0 += 4 * NGW) {
        float mg[4][3], lg[4][3]; v4u pv[4][3];
#pragma unroll
        for (int r = 0; r < 4; ++r)
#pragma unroll
            for (int g = 0; g < 3; ++g) { const size_t row = (size_t)g * M + m0 + r * NGW; mg[r][g] = MLM[row * 4 + hg]; lg[r][g] = MLL[row * 4 + hg]; pv[r][g] = *((const v4u*)(OG + row * AOW) + F.lane); }
#pragma unroll
        for (int r = 0; r < 4; ++r) {
            const float mm = fmaxf(mg[r][0], fmaxf(mg[r][1], mg[r][2]));
            float wg[3], wsum = 0.f;
#pragma unroll
            for (int g = 0; g < 3; ++g) { wg[g] = lg[r][g] * __builtin_amdgcn_exp2f((mg[r][g] - mm) * LOG2E); wsum += wg[g]; }
            const float winv = 1.0f / wsum;
            f32x4 a0 = (f32x4){0.f, 0.f, 0.f, 0.f}, a1 = a0;
#pragma unroll
            for (int g = 0; g < 3; ++g) { const v4u p = pv[r][g];
                a0 += (f32x4){bf_lo(p.x), bf_hi(p.x), bf_lo(p.y), bf_hi(p.y)} * wg[g]; a1 += (f32x4){bf_lo(p.z), bf_hi(p.z), bf_lo(p.w), bf_hi(p.w)} * wg[g]; }
            a0 = a0 * winv; a1 = a1 * winv;
            v4u o; o.x = pk2(a0.x, a0.y); o.y = pk2(a0.z, a0.w); o.z = pk2(a1.x, a1.y); o.w = pk2(a1.z, a1.w);
            *((v4u*)(OA + (size_t)(m0 + r * NGW) * AOW) + F.lane) = o;
        }
    }
}

constexpr int RET_KROW = 528;
constexpr int RET_VROW = 96;
constexpr int RET_SROW = 528;
constexpr int RET_KOFF = 0, RET_VOFF = 128 * RET_KROW, RET_V2OFF = RET_VOFF + 128 * RET_VROW, RET_SOFF = RET_V2OFF + 128 * RET_VROW;
static_assert(RET_SOFF + 2 * 32 * RET_SROW <= LDSCTL_OFF, "retention LDS map");
__device__ __forceinline__ float ret_log2_gamma(int h) {
    return h == 0 ? -4.5803689613e-02f : h == 1 ? -2.2720076500e-02f : h == 2 ? -1.1315313228e-02f : h == 3 ? -5.6465631411e-03f
         : h == 4 ? -2.8205190624e-03f : h == 5 ? -1.4095702547e-03f : h == 6 ? -7.0461297659e-04f : -3.5226347163e-04f;
}
__device__ __forceinline__ void retention_scores_phase(Frame& F) {
    const bf16* QR = (const bf16*)(F.ws + WS_QR); const bf16* KR = (const bf16*)(F.ws + WS_KR); bf16* PB = (bf16*)(F.ws + WS_PR);
    LAS unsigned char* Kl = F.lds + RET_KOFF;
    const int w = F.wave, lane = F.lane, r16 = lane & 15, g4 = lane >> 4;
    const int it = (w < 4) ? w : 11 - w;
    const int krow = F.tid >> 5, kch = F.tid & 31;
    const LAS unsigned char* k_row = Kl + r16 * RET_KROW + 16 * g4;
    const int iq = 16 * it + r16;
#define R0_REQUEST(u_) do { const int bh_ = (u_) >> 7, n_ = (u_) & 127; const size_t m_ = (size_t)bh_ * SEQ + (size_t)n_ * 128; \
        _Pragma("unroll") for (int c = 0; c < 8; ++c) kreg[c] = *(const v4u*)(KR + (m_ + krow + 16 * c) * 256 + kch * 8); \
        { const bf16* qp = QR + (m_ + 16 * it) * 256 + lane * 8; _Pragma("unroll") for (int ks = 0; ks < 8; ++ks) qn[ks] = *(const bf16x8*)(qp + 512 * ks); } } while (0)
    v4u kreg[8]; bf16x8 qn[8];
    if (F.vcu < 2048) R0_REQUEST(F.vcu);
    for (int u = F.vcu; u < 2048; u += F.G) {
        const int bh = u >> 7, n = u & 127, h = bh & 7;
        const float l2g = ret_log2_gamma(h);
        const size_t m0 = (size_t)bh * SEQ + (size_t)n * 128;
#pragma unroll
        for (int c = 0; c < 8; ++c) *(LAS v4u*)(Kl + (krow + 16 * c) * RET_KROW + kch * 16) = kreg[c];
        bf16x8 qf[8];
#pragma unroll
        for (int ks = 0; ks < 8; ++ks) qf[ks] = qn[ks];
        { const int un = (u + F.G < 2048) ? u + F.G : u; if (un != u) R0_REQUEST(un); }
        RAW_BARRIER();
        { const LAS unsigned char* k_tr = Kl + (4 * g4 + (r16 >> 2)) * RET_KROW + (32 * w + 4 * (r16 & 3)) * 2;
          bf16* kw = (bf16*)KR + m0 * 256 + (size_t)(w * 8) * 512 + lane * 8;
#pragma unroll
          for (int ks = 0; ks < 4; ++ks) {
              float fd[8];
#pragma unroll
              for (int j = 0; j < 8; ++j) fd[j] = __builtin_amdgcn_exp2f((float)(127 - (32 * ks + 16 * (j >> 2) + 4 * g4 + (j & 3))) * l2g);
#pragma unroll
              for (int a = 0; a < 2; ++a) {
                  const v4i16_t lo = lds_tr(k_tr + (32 * ks) * RET_KROW + 32 * a), hi = lds_tr(k_tr + (32 * ks + 16) * RET_KROW + 32 * a);
                  v4u o;
                  o.x = pg8::cvt_pk_bf16(bf_lo((unsigned)(unsigned short)lo[0]) * fd[0], bf_lo((unsigned)(unsigned short)lo[1]) * fd[1]);
                  o.y = pg8::cvt_pk_bf16(bf_lo((unsigned)(unsigned short)lo[2]) * fd[2], bf_lo((unsigned)(unsigned short)lo[3]) * fd[3]);
                  o.z = pg8::cvt_pk_bf16(bf_lo((unsigned)(unsigned short)hi[0]) * fd[4], bf_lo((unsigned)(unsigned short)hi[1]) * fd[5]);
                  o.w = pg8::cvt_pk_bf16(bf_lo((unsigned)(unsigned short)hi[2]) * fd[6], bf_lo((unsigned)(unsigned short)hi[3]) * fd[7]);
                  *(v4u*)(kw + (size_t)(4 * a + ks) * 512) = o;
              }
          } }
        bf16* pw_base = PB + (((size_t)u * 8 + it) * 4) * 512 + lane * 8;
#pragma unroll
        for (int sp = 0; sp < 4; ++sp) {
            if (2 * sp <= it) {
                f32x4 sc2[2];
#pragma unroll
                for (int hh = 0; hh < 2; ++hh) {
                    const int jt = 2 * sp + hh;
                    sc2[hh] = (f32x4){0.f, 0.f, 0.f, 0.f};
                    if (jt <= it) {
#pragma unroll
                        for (int ks = 0; ks < 8; ++ks) { const bf16x8 a = *(const LAS bf16x8*)(k_row + (16 * jt) * RET_KROW + 64 * ks); sc2[hh] = __builtin_amdgcn_mfma_f32_16x16x32_bf16(a, qf[ks], sc2[hh], 0, 0, 0); }
#pragma unroll
                        for (int q = 0; q < 4; ++q) { const int j = 16 * jt + 4 * g4 + q; sc2[hh][q] = (iq >= j) ? sc2[hh][q] * __builtin_amdgcn_exp2f((float)(iq - j) * l2g) : 0.f; }
                    }
                }
                v4u pw; pw.x = pg8::cvt_pk_bf16(sc2[0][0], sc2[0][1]); pw.y = pg8::cvt_pk_bf16(sc2[0][2], sc2[0][3]); pw.z = pg8::cvt_pk_bf16(sc2[1][0], sc2[1][1]); pw.w = pg8::cvt_pk_bf16(sc2[1][2], sc2[1][3]);
                *(v4u*)(pw_base + 512 * sp) = pw;
            }
        }
        RAW_BARRIER();
    }
#undef R0_REQUEST
}
constexpr int RS_VOFF = 0, RS_SOFF = 2 * 128 * RET_VROW;
__device__ __forceinline__ void retention_phase(Frame& F, size_t gst_ws) {
    const bf16* QR = (const bf16*)(F.ws + WS_QR); const bf16* KR = (const bf16*)(F.ws + WS_KR); bf16* VR = (bf16*)(F.ws + WS_VR); const bf16* PB = (const bf16*)(F.ws + WS_PR);
    LAS unsigned char* Vl = F.lds + RS_VOFF; LAS unsigned char* Sl = F.lds + RS_SOFF;
    const int w = F.wave, lane = F.lane, r16 = lane & 15, g4 = lane >> 4, trq = r16 >> 2, trp = r16 & 3;
    const int it = (w < 4) ? w : 11 - w;
    const int vrow = F.tid >> 2, vch = F.tid & 3;
    for (int u = F.vcu; u < 256; u += F.G) {
        const int bh = u >> 4, sl = u & 15, h = bh & 7;
        const float l2g = ret_log2_gamma(h);
        const float gC = __builtin_amdgcn_exp2f(128.0f * l2g);
        const float oscale = __builtin_amdgcn_exp2f((float)(16 * it + r16 + 1) * l2g);
        bf16* vg = VR + (((size_t)bh * 16 + sl) * SEQ + vrow) * 32 + vch * 8;
        const bf16* qg = QR + ((size_t)bh * SEQ + 16 * it) * 256 + lane * 8;
        const bf16* kg = KR + ((size_t)bh * SEQ) * 256 + (size_t)(w * 8) * 512 + lane * 8;
        const bf16* pg = PB + (((size_t)(bh * 128) * 8 + it) * 4) * 512 + lane * 8;
        bf16* og = VR + (((size_t)bh * 16 + sl) * SEQ + 16 * it + r16) * 32 + 4 * g4;
        unsigned long long* gst = (unsigned long long*)(F.ws + gst_ws) + (((size_t)(bh >> 3) * SEQ + 16 * it + r16) * 8 + h) * 2;
        f32x4 st[2][2];
#pragma unroll
        for (int a = 0; a < 2; ++a)
#pragma unroll
            for (int e = 0; e < 2; ++e) st[a][e] = (f32x4){0.f, 0.f, 0.f, 0.f};
        for (int i = F.tid; i < 32 * RET_SROW / 4; i += NWAVES * 64) ((LAS unsigned*)Sl)[i] = 0u;
        v4u vreg; bf16x8 qf[8], pf[4], kf[8];
        vreg = *(const v4u*)vg;
#pragma unroll
        for (int ks = 0; ks < 8; ++ks) qf[ks] = *(const bf16x8*)(qg + 512 * ks);
#pragma unroll
        for (int s = 0; s < 4; ++s) { pf[s] = (bf16x8){0, 0, 0, 0, 0, 0, 0, 0}; if (2 * s <= it) pf[s] = *(const bf16x8*)(pg + 512 * s); }
#pragma unroll
        for (int f = 0; f < 8; ++f) kf[f] = *(const bf16x8*)(kg + 512 * f);
        *(LAS v4u*)(Vl + vrow * RET_VROW + vch * 16) = vreg;
        __syncthreads();
        const int v_pv = (4 * g4 + trq) * RET_VROW + (4 * trp) * 2;
        for (int n = 0; n < 128; ++n) {
            const int cur = n & 1;
            const LAS unsigned char* Vc = Vl + cur * (128 * RET_VROW); LAS unsigned char* Vn = Vl + (cur ^ 1) * (128 * RET_VROW);
            const LAS unsigned char* Sc = Sl + cur * (32 * RET_SROW); LAS unsigned char* Sn = Sl + (cur ^ 1) * (32 * RET_SROW);
            const size_t nrow = (size_t)((n < 127 ? n + 1 : n) * 128);
            vreg = *(const v4u*)(vg + nrow * 32);
            f32x4 o[2]; bf16x8 sb[2][8];
#pragma unroll
            for (int et = 0; et < 2; ++et) {
                const LAS unsigned char* sp = Sc + (16 * et + r16) * RET_SROW + 16 * g4;
#pragma unroll
                for (int ks = 0; ks < 8; ++ks) sb[et][ks] = *(const LAS bf16x8*)(sp + 64 * ks);
            }
            __builtin_amdgcn_sched_barrier(0);
            o[0] = (f32x4){0.f, 0.f, 0.f, 0.f}; o[1] = o[0];
#pragma unroll
            for (int ks = 0; ks < 8; ++ks)
#pragma unroll
                for (int et = 0; et < 2; ++et) o[et] = __builtin_amdgcn_mfma_f32_16x16x32_bf16(sb[et][ks], qf[ks], o[et], 0, 0, 0);
#pragma unroll
            for (int ks = 0; ks < 8; ++ks) qf[ks] = *(const bf16x8*)(qg + nrow * 256 + 512 * ks);
            bf16x8 vfr[4][2];
#pragma unroll
            for (int ks = 0; ks < 4; ++ks)
#pragma unroll
                for (int et = 0; et < 2; ++et) vfr[ks][et] = cat8(lds_tr(Vc + v_pv + (32 * ks) * RET_VROW + 32 * et), lds_tr(Vc + v_pv + (32 * ks + 16) * RET_VROW + 32 * et));
            __builtin_amdgcn_sched_barrier(0);
            o[0] = o[0] * oscale; o[1] = o[1] * oscale;
#pragma unroll
            for (int s = 0; s < 4; ++s) {
                if (2 * s <= it) {
#pragma unroll
                    for (int et = 0; et < 2; ++et) o[et] = __builtin_amdgcn_mfma_f32_16x16x32_bf16(vfr[s][et], pf[s], o[et], 0, 0, 0);
                    pf[s] = *(const bf16x8*)(pg + nrow * 128 + 512 * s);
                }
            }
            {
                bf16* op = og + (size_t)n * 128 * 32;
                v2u w0; w0.x = pg8::cvt_pk_bf16(o[0][0], o[0][1]); w0.y = pg8::cvt_pk_bf16(o[0][2], o[0][3]);
                v2u w1; w1.x = pg8::cvt_pk_bf16(o[1][0], o[1][1]); w1.y = pg8::cvt_pk_bf16(o[1][2], o[1][3]);
                *(v2u*)op = w0; *(v2u*)(op + 16) = w1;
            }
            {
                float s1 = ((o[0][0] + o[0][1]) + (o[0][2] + o[0][3])) + ((o[1][0] + o[1][1]) + (o[1][2] + o[1][3]));
                float s2 = ((o[0][0] * o[0][0] + o[0][1] * o[0][1]) + (o[0][2] * o[0][2] + o[0][3] * o[0][3])) + ((o[1][0] * o[1][0] + o[1][1] * o[1][1]) + (o[1][2] * o[1][2] + o[1][3] * o[1][3]));
                s1 = pg8::xor32_sum(pg8::xor16_sum(s1)); s2 = pg8::xor32_sum(pg8::xor16_sum(s2));
                if (g4 == 0) {
                    unsigned long long* sp = gst + ((size_t)n * 128 * 8) * 2;
                    atomicAdd(sp, (unsigned long long)(long long)__builtin_rintf(s1 * 1048576.0f)); atomicAdd(sp + 1, (unsigned long long)__builtin_rintf(s2 * 1048576.0f));
                }
            }
#pragma unroll
            for (int a = 0; a < 2; ++a)
#pragma unroll
                for (int et = 0; et < 2; ++et) st[a][et] = st[a][et] * gC;
#pragma unroll
            for (int ks = 0; ks < 4; ++ks)
#pragma unroll
                for (int a = 0; a < 2; ++a)
#pragma unroll
                    for (int et = 0; et < 2; ++et) st[a][et] = __builtin_amdgcn_mfma_f32_16x16x32_bf16(kf[4 * a + ks], vfr[ks][et], st[a][et], 0, 0, 0);
#pragma unroll
            for (int f = 0; f < 8; ++f) kf[f] = *(const bf16x8*)(kg + nrow * 256 + 512 * f);
#pragma unroll
            for (int a = 0; a < 2; ++a)
#pragma unroll
                for (int et = 0; et < 2; ++et) {
                    v2u wv; wv.x = pg8::cvt_pk_bf16(st[a][et][0], st[a][et][1]); wv.y = pg8::cvt_pk_bf16(st[a][et][2], st[a][et][3]);
                    *(LAS v2u*)(Sn + (16 * et + r16) * RET_SROW + (32 * w + 16 * a + 4 * g4) * 2) = wv;
                }
            *(LAS v4u*)(Vn + vrow * RET_VROW + vch * 16) = vreg;
            RAW_BARRIER();
        }
        __syncthreads();
    }
}
__device__ __forceinline__ void retention_stats_rows(Frame& F) {
    const bf16* VR = (const bf16*)(F.ws + WS_VR); float* st = (float*)(F.ws + WS_GST);
    const int gw = F.vcu * NWAVES + F.wave, NGW = F.G * NWAVES;
    for (int t0 = gw; t0 < M * 8; t0 += 4 * NGW) {
        v4u ov[4];
#pragma unroll
        for (int r = 0; r < 4; ++r) {
            const int t = t0 + r * NGW;
            const int mm = t >> 3, hh = t & 7, bb = mm / SEQ, tt = mm - bb * SEQ;
            ov[r] = *(const v4u*)(VR + ((((size_t)(bb * 8 + hh) * 16 + (F.lane >> 2)) * SEQ + tt) * 32 + (F.lane & 3) * 8));
        }
#pragma unroll
        for (int r = 0; r < 4; ++r) {
            float x[8] = {bf_lo(ov[r].x), bf_hi(ov[r].x), bf_lo(ov[r].y), bf_hi(ov[r].y), bf_lo(ov[r].z), bf_hi(ov[r].z), bf_lo(ov[r].w), bf_hi(ov[r].w)};
            float sm = 0.f;
#pragma unroll
            for (int j = 0; j < 8; ++j) sm += x[j];
            const float mu = wave_sum(sm) * (1.0f / 512.0f);
            float q = 0.f;
#pragma unroll
            for (int j = 0; j < 8; ++j) { x[j] -= mu; q += x[j] * x[j]; }
            const float rstd = 1.0f / sqrtf(wave_sum(q) * (1.0f / 512.0f) + GN_EPS);
            if (F.lane == 0) { pg8::f32x2_t o = {mu, rstd}; *(pg8::f32x2_t*)(st + (size_t)(t0 + r * NGW) * 2) = o; }
        }
    }
}

constexpr int PH_PER_LAYER = 17;
constexpr int N_PHASES = DEPTH * PH_PER_LAYER + 1;
constexpr int PTRS_OFF = LDSCTL_OFF + 64;
struct Args { const float* in[15]; float* out; unsigned char* ws; int ph_lo, ph_hi, li, pad; };
__device__ __forceinline__ unsigned char* ldptr(LAS unsigned char* lds, int k) {
    volatile LAS unsigned* p = (volatile LAS unsigned*)(lds + PTRS_OFF + 8 * k);
    const unsigned lo = __builtin_amdgcn_readfirstlane(p[0]), hi = __builtin_amdgcn_readfirstlane(p[1]);
    GAS unsigned char* g = (GAS unsigned char*)(((unsigned long long)hi << 32) | lo);
    return (unsigned char*)g;
}
__device__ __forceinline__ void make_frame(Frame& F, LAS unsigned char* lds) {
    int tid = threadIdx.x; asm volatile("" : "+v"(tid));
    int bx = blockIdx.x; asm volatile("" : "+s"(bx));
    int G = gridDim.x; asm volatile("" : "+s"(G));
    F.lds = lds; F.tid = tid; F.lane = tid & 63; F.wave = __builtin_amdgcn_readfirstlane(tid >> 6);
    F.G = G; F.bx = bx; F.vcu = (G % 8 == 0) ? (bx % 8) * (G / 8) + bx / 8 : bx;
    F.ws = ldptr(lds, 16);
}
#define IN_PTR(k) ((const float*)ldptr(F.lds, (k)))
#define OUT_PTR() ((float*)ldptr(F.lds, 15))
#define SSQ_PTR(j) ((unsigned long long*)(F.ws + WS_SSQ + (size_t)(j) * SSQ_BYTES))
#define XB_PTR() ((bf16*)ldptr(F.lds, 15))

__device__ __forceinline__ void ph_prologue(LAS unsigned char* lds, int layer) {
    Frame F; make_frame(F, lds);
    LayerW L;
    L.g1 = IN_PTR(2) + (size_t)layer * D * FF; L.u1 = IN_PTR(3) + (size_t)layer * D * FF; L.d1 = IN_PTR(4) + (size_t)layer * FF * D;
    L.win = IN_PTR(6) + (size_t)layer * D * INC; L.pa = IN_PTR(7) + (size_t)layer * AOW * D; L.pr = IN_PTR(8) + (size_t)layer * RV * D; L.wo = IN_PTR(9) + (size_t)layer * D * D;
    L.g2 = IN_PTR(11) + (size_t)layer * D * FF; L.u2 = IN_PTR(12) + (size_t)layer * D * FF; L.d2 = IN_PTR(13) + (size_t)layer * FF * D;
    L.n1 = IN_PTR(1) + (size_t)layer * D; L.nm = IN_PTR(5) + (size_t)layer * D; L.n2 = IN_PTR(10) + (size_t)layer * D;
    convert_weights(F, L);
    if (layer == 0) stream_rows_input(F, IN_PTR(0), XB_PTR(), SSQ_PTR(0));
}
__device__ __forceinline__ void ph_tables(LAS unsigned char* lds) {
    Frame F; make_frame(F, lds); rope_tables(F);
    unsigned long long* z = SSQ_PTR(1);
    for (int i = F.vcu * (NWAVES * 64) + F.tid; i < 3 * DEPTH * M; i += F.G * NWAVES * 64) z[i] = 0ull;
    unsigned long long* zg = (unsigned long long*)(F.ws + WS_H);
    for (int i = F.vcu * (NWAVES * 64) + F.tid; i < (int)(DEPTH * GST_BYTES / 8); i += F.G * NWAVES * 64) zg[i] = 0ull;
}
__device__ __forceinline__ void ph_gateup(LAS unsigned char* lds, size_t w_off, int site) {
    Frame F; make_frame(F, lds);
    pg8::Gemm g{XB_PTR(), (const bf16*)(F.ws + w_off), M, 2 * FF, D}; pg8::StaticOrder S; S.init(M, 2 * FF, F.G, F.bx);
    pg8::EpiGateUp E{(bf16*)(F.ws + WS_HID), FF, SSQ_PTR(site)};
    pg8::gemm_phase<pg8::EpiGateUp, pg8::StaticOrder>(F.lds, F.tid, g, S, E);
}
__device__ __forceinline__ void ph_res(LAS unsigned char* lds, size_t a_off, size_t w_off, int K, float scale, bool last, int site, int rev, int a_tiled) {
    Frame F; make_frame(F, lds);
    const bf16* base = XB_PTR(); bf16* xout = last ? (bf16*)(F.ws + WS_H) : XB_PTR();
    pg8::Gemm g{(const bf16*)(F.ws + a_off), (const bf16*)(F.ws + w_off), M, D, K, a_tiled}; pg8::StaticOrder S; S.init(M, D, F.G, F.bx, 4, rev);
    pg8::EpiRes E{base, xout, D, scale, SSQ_PTR(site)};
    pg8::gemm_phase<pg8::EpiRes, pg8::StaticOrder>(F.lds, F.tid, g, S, E);
}
__device__ __forceinline__ void ph_in_a(LAS unsigned char* lds, int site) {
    Frame F; make_frame(F, lds);
    pg8::Gemm g{XB_PTR(), (const bf16*)(F.ws + WS_WIN), M, 3 * AW, D}; pg8::StaticOrder S; S.init(M, 3 * AW, F.G, F.bx);
    pg8::EpiInA E{(bf16*)(F.ws + WS_QA), (WS_KA - WS_QA) / 2, (const float*)(F.ws + WS_COSA), (const float*)(F.ws + WS_SINA), SEQ, SSQ_PTR(site)};
    pg8::gemm_phase<pg8::EpiInA, pg8::StaticOrder>(F.lds, F.tid, g, S, E);
}
__device__ __forceinline__ void ph_in_r(LAS unsigned char* lds, int site) {
    Frame F; make_frame(F, lds);
    pg8::Gemm g{XB_PTR(), (const bf16*)(F.ws + WS_WIN) + (size_t)(3 * AW) * D, M, 2 * RQK + RV, D}; pg8::StaticOrder S; S.init(M, 2 * RQK + RV, F.G, F.bx);
    pg8::EpiInR E{(bf16*)(F.ws + WS_QR), (WS_KR - WS_QR) / 2, (bf16*)(F.ws + WS_VR), (WS_OR - WS_VR) / 2, (const float*)(F.ws + WS_COSR), (const float*)(F.ws + WS_SINR), SEQ, SSQ_PTR(site)};
    pg8::gemm_phase<pg8::EpiInR, pg8::StaticOrder>(F.lds, F.tid, g, S, E);
}
__device__ __forceinline__ void ph_in_g(LAS unsigned char* lds, int site) {
    Frame F; make_frame(F, lds);
    pg8::Gemm g{XB_PTR(), (const bf16*)(F.ws + WS_WIN) + (size_t)(3 * AW + 2 * RQK + 2 * RV) * D, M, 2 * D, D}; pg8::StaticOrder S; S.init(M, 2 * D, F.G, F.bx);
    pg8::EpiGates E{(bf16*)(F.ws + WS_SGA), (WS_SGB - WS_SGA) / 2, SSQ_PTR(site)};
    pg8::gemm_phase<pg8::EpiGates, pg8::StaticOrder>(F.lds, F.tid, g, S, E);
}
__device__ __forceinline__ void ph_gated(LAS unsigned char* lds, size_t a_off, size_t w_off, int K, size_t gate_off, bool has_add, size_t add_off) {
    Frame F; make_frame(F, lds);
    pg8::Gemm g{(const bf16*)(F.ws + a_off), (const bf16*)(F.ws + w_off), M, D, K}; pg8::StaticOrder S; S.init(M, D, F.G, F.bx, 4);
    pg8::EpiGated E{(const bf16*)(F.ws + gate_off), has_add ? (const bf16*)(F.ws + add_off) : nullptr, (bf16*)(F.ws + gate_off), D};
    pg8::gemm_phase<pg8::EpiGated, pg8::StaticOrder>(F.lds, F.tid, g, S, E);
}
__device__ __forceinline__ void ph_attn(LAS unsigned char* lds) { Frame F; make_frame(F, lds); attn_phase(F); }
__device__ __forceinline__ void ph_attn_merge(LAS unsigned char* lds) { Frame F; make_frame(F, lds); attn_merge_rows(F); }
__device__ __forceinline__ void ph_ret_scores(LAS unsigned char* lds) { Frame F; make_frame(F, lds); retention_scores_phase(F); }
__device__ __forceinline__ void ph_ret(LAS unsigned char* lds, size_t gst_ws) { Frame F; make_frame(F, lds); retention_phase(F, gst_ws); }
__device__ __forceinline__ void ph_ret_stats(LAS unsigned char* lds) { Frame F; make_frame(F, lds); retention_stats_rows(F); }
__device__ __forceinline__ void ph_g(LAS unsigned char* lds, int site, int layer) {
    Frame F; make_frame(F, lds);
    pg8::Gemm g{XB_PTR(), (const bf16*)(F.ws + WS_WIN) + (size_t)(3 * AW + 2 * RQK + RV) * D, M, RV, D}; pg8::StaticOrder S; S.init(M, RV, F.G, F.bx);
    static_assert(pg8::EpiG::seq == SEQ, "EpiG seq");
    pg8::EpiG E{(const bf16*)(F.ws + WS_VR), (bf16*)(F.ws + WS_OR), (const unsigned long long*)(F.ws + WS_H + (size_t)layer * GST_BYTES), SSQ_PTR(site)};
    pg8::gemm_phase<pg8::EpiG, pg8::StaticOrder>(F.lds, F.tid, g, S, E);
}
__device__ __forceinline__ void ph_final(LAS unsigned char* lds) { Frame F; make_frame(F, lds); norm_rows_final(F, (const bf16*)(F.ws + WS_H), IN_PTR(14), OUT_PTR()); }

#ifndef PHMASK
#define PHMASK 0x1ffff
#endif
__global__ void __launch_bounds__(NWAVES * 64, 2) fwd_kernel(Args args) {
    extern __shared__ __attribute__((aligned(16))) unsigned char lds_raw[];
    LAS unsigned char* lds = (LAS unsigned char*)lds_raw;
    for (int u = threadIdx.x; u < (LDS_BYTES - LDSCTL_OFF) / 4; u += NWAVES * 64) ((LAS unsigned*)(lds + LDSCTL_OFF))[u] = 0u;
    __syncthreads();
    if (threadIdx.x < 17) {
        const int k = threadIdx.x;
        unsigned long long v = (k < 15) ? (unsigned long long)args.in[k < 15 ? k : 0] : (k == 15 ? (unsigned long long)args.out : (unsigned long long)args.ws);
        *(LAS unsigned long long*)(lds + PTRS_OFF + 8 * k) = v;
    }
    __syncthreads();
    volatile LAS unsigned* MISC = (volatile LAS unsigned*)(lds + MISC_OFF);
    XcdBarrier bar = xcd_barrier_post((unsigned*)(ldptr(lds, 16) + WS_CTL) + CW_BAR + args.li * XCD_BAR_WORDS, MISC + 8);
    const int lo = args.ph_lo, hi = args.ph_hi;
#define IN(k) (((PHMASK >> (((k) - pb) & 31)) & 1) && lo <= (k) && (k) < hi)
#define SEAM(k) do { if ((k) + 1 < hi) xcd_barrier(bar); } while (0)
    { const int pb = 0; if (IN(0)) ph_tables(lds); }
#define RUN(k, call) do { if (IN(pb + (k))) { call; SEAM(pb + (k)); } } while (0)
    for (int layer = 0; layer < DEPTH; ++layer) {
        const int pb = layer * PH_PER_LAYER;
        RUN(0, ph_prologue(lds, layer));
        RUN(1, ph_gateup(lds, WS_WGU1, 3 * layer));
        RUN(2, ph_res(lds, WS_HID, WS_WD1, FF, 0.5f, false, 3 * layer + 1, 1, 1));
        RUN(4, ph_in_a(lds, 3 * layer + 1));
        RUN(5, ph_attn(lds));
        if (IN(pb + 7)) { ph_attn_merge(lds); ph_in_r(lds, 3 * layer + 1); SEAM(pb + 7); }
        if (IN(pb + 8)) { ph_ret_scores(lds); xcd_barrier(bar); ph_ret(lds, WS_H + (size_t)layer * GST_BYTES); SEAM(pb + 8); }
        if (IN(pb + 9)) { ph_in_g(lds, 3 * layer + 1); SEAM(pb + 9); }
        RUN(10, ph_g(lds, 3 * layer + 1, layer));
        if (IN(pb + 12)) {
            ph_gated(lds, WS_OA, WS_WPA, AOW, WS_SGA, false, 0);
            ph_gated(lds, WS_OR, WS_WPR, RV, WS_SGB, true, WS_SGA);
            SEAM(pb + 12);
        }
        RUN(13, ph_res(lds, WS_SGB, WS_WOUT, D, 1.0f, false, 3 * layer + 2, 0, 0));
        RUN(15, ph_gateup(lds, WS_WGU2, 3 * layer + 2));
        RUN(16, ph_res(lds, WS_HID, WS_WD2, FF, 0.5f, layer == DEPTH - 1, 3 * layer + 3, 1, 1));
    }
    { const int pb = DEPTH * PH_PER_LAYER; if (IN(pb)) ph_final(lds); }
#undef RUN
#undef IN
#undef SEAM
}

#ifndef MK_PER_PHASE
#define MK_PER_PHASE 0
#endif
extern "C" void kernel_launch(void* const* d_in, const int* in_sizes, int n_in, void* d_out, int out_size, void* d_ws, size_t ws_size, hipStream_t stream) {
    static int grid = 0;
    if (grid == 0) {
        if (n_in != 15 || out_size != M * D || ws_size < WS_END) { fprintf(stderr, "kernel_launch: unexpected shapes (n_in %d, out %d, ws %zu)\n", n_in, out_size, ws_size); grid = -1; return; }
        int dev = 0, cus = 0, per_cu = 0;
        if (hipGetDevice(&dev) != hipSuccess || hipDeviceGetAttribute(&cus, hipDeviceAttributeMultiprocessorCount, dev) != hipSuccess) { grid = -1; return; }
        if (hipFuncSetAttribute((const void*)fwd_kernel, hipFuncAttributeMaxDynamicSharedMemorySize, LDS_BYTES) != hipSuccess) { fprintf(stderr, "kernel_launch: hipFuncSetAttribute failed\n"); grid = -1; return; }
        if (hipOccupancyMaxActiveBlocksPerMultiprocessor(&per_cu, (const void*)fwd_kernel, NWAVES * 64, LDS_BYTES) != hipSuccess || per_cu < 1) fprintf(stderr, "kernel_launch: occupancy query reports %d\n", per_cu);
        (void)hipGetLastError();
        grid = cus;
    }
    if (grid < 0) return;
    (void)hipMemsetAsync((char*)d_ws + WS_CTL, 0, CTL_ZERO_BYTES, stream);
    Args a{};
    for (int i = 0; i < 15; ++i) a.in[i] = (const float*)d_in[i];
    a.out = (float*)d_out; a.ws = (unsigned char*)d_ws;
#if MK_PER_PHASE
    for (int p = 0; p < N_PHASES; ++p) { a.ph_lo = p; a.ph_hi = p + 1; a.li = p; hipLaunchKernelGGL(fwd_kernel, dim3(grid), dim3(NWAVES * 64), LDS_BYTES, stream, a); }
#else
    a.ph_lo = 0; a.ph_hi = N_PHASES; a.li = 0;
    hipLaunchKernelGGL(fwd_kernel, dim3(grid), dim3(NWAVES * 64), LDS_BYTES, stream, a);
#endif
}
```

```cpp
#include <hip/hip_runtime.h>
#include <cstdio>
#include <cstdint>

namespace pg8 {
#define PG8_LAS __attribute__((address_space(3)))
typedef unsigned short bf16_t;
typedef short bf16x8 __attribute__((ext_vector_type(8)));
typedef float f32x4 __attribute__((ext_vector_type(4)));
typedef unsigned u32x4 __attribute__((ext_vector_type(4)));
constexpr int BM = 256, BK = 64, HALF = 128, HTB = HALF * BK * 2, STAGE_BYTES = 8 * HTB, NXCD = 8, WGM = 8;

__host__ __device__ __forceinline__ int lds_byte(int r, int c) { const int st = (r >> 4) * 2 + (c >> 5), rr = r & 15, cc = c & 31, ob = rr * 64 + cc * 2; return st * 1024 + (ob ^ (((ob >> 9) & 1) << 5)); }
__host__ __device__ __forceinline__ void stage_rc(int b, int& R, int& C) { const int st = b / 1024, sb = b % 1024, swz = sb ^ (((sb >> 9) & 1) << 5); R = (st >> 1) * 16 + swz / 64; C = (st & 1) * 32 + (swz % 64) / 2; }
__host__ __device__ __forceinline__ int perm32(int rho) { const int n = rho >> 4, i = rho & 15; return 8 * (i >> 2) + 4 * n + (i & 3); }

struct Unit { int pm, pn; };
struct Gemm { const bf16_t* A; const bf16_t* Bt; int M, N, K; int a_tiled = 0; };

struct StaticOrder {
    int nM, nN, nwg, G, c, wgm, rev;
    __host__ __device__ void init(int M, int N, int G_, int c_, int wgm_ = WGM, int rev_ = 0) { nM = M / BM; nN = N / BM; nwg = nM * nN; G = G_; c = c_; wgm = wgm_; rev = rev_; }
    __host__ __device__ bool next(int i, Unit& u) const {
        const long L = (long)i * G + c; if (L >= nwg) return false;
        int wgid = (int)L; { const int q = nwg / NXCD, r = nwg % NXCD, xcd = wgid % NXCD, off = wgid / NXCD; wgid = (xcd < r ? xcd * (q + 1) : r * (q + 1) + (xcd - r) * q) + off; }
        const int nig = wgm * nN, gid = wgid / nig, fm = gid * wgm, gsz = (nM - fm) < wgm ? (nM - fm) : wgm;
        u.pm = fm + ((wgid % nig) % gsz); u.pn = (wgid % nig) / gsz; if (rev) u.pm = nM - 1 - u.pm; return true;
    }
    __device__ __forceinline__ void a_ready(const Unit&) const {}
    __device__ __forceinline__ void done(const Unit&) const {}
};

typedef float f32x2_t __attribute__((ext_vector_type(2))); typedef double f64x2_t __attribute__((ext_vector_type(2))); typedef __bf16 bf16x2_t __attribute__((ext_vector_type(2)));
__device__ __forceinline__ unsigned cvt_pk_bf16(float lo, float hi) { f32x2_t v = {lo, hi}; bf16x2_t b = __builtin_convertvector(v, bf16x2_t); return __builtin_bit_cast(unsigned, b); }
#define PG8_SWAP_PAIR(op, v, x, y) unsigned x, y; { unsigned b_; asm volatile("v_mov_b32 %0, %1" : "=v"(b_) : "v"(__builtin_bit_cast(unsigned, v))); \
        const auto r_ = __builtin_amdgcn_##op(__builtin_bit_cast(unsigned, v), b_, false, false); x = r_[0]; y = r_[1]; asm volatile("" : "+v"(x)); asm volatile("" : "+v"(y)); }
__device__ __forceinline__ float xor16_sum(float v) { PG8_SWAP_PAIR(permlane16_swap, v, x, y) return __builtin_bit_cast(float, x) + __builtin_bit_cast(float, y); }
__device__ __forceinline__ float xor32_sum(float v) { PG8_SWAP_PAIR(permlane32_swap, v, x, y) return __builtin_bit_cast(float, x) + __builtin_bit_cast(float, y); }
__device__ __forceinline__ float xor16_max(float v) { PG8_SWAP_PAIR(permlane16_swap, v, x, y) return __builtin_fmaxf(__builtin_bit_cast(float, x), __builtin_bit_cast(float, y)); }
__device__ __forceinline__ float xor32_max(float v) { PG8_SWAP_PAIR(permlane32_swap, v, x, y) return __builtin_fmaxf(__builtin_bit_cast(float, x), __builtin_bit_cast(float, y)); }
__device__ __forceinline__ float fast_sigmoid(float x) { return __builtin_amdgcn_rcpf(1.0f + __builtin_amdgcn_exp2f(-1.44269504089f * x)); }

constexpr float SSQ_FIX = 65536.0f;
constexpr int SSQ_LDS_OFF = 131072;
typedef const PG8_LAS unsigned long long* ssq_lds_t;
#define PG8_ROW_RSTD(rs, rl, r0) float rs[2][4]; _Pragma("unroll") for (int ai_ = 0; ai_ < 2; ++ai_) _Pragma("unroll") for (int m_ = 0; m_ < 4; ++m_) \
        rs[ai_][m_] = __builtin_amdgcn_rsqf((float)rl[(r0) + ai_ * HALF + m_ * 16] * (1.0f / (SSQ_FIX * 2048.0f)) + 1e-6f);


struct EpiGateUp {
    static constexpr bool PERM = true, AFTER_DRAIN = false, ROWNORM = true, HAS_PRE = false;
    bf16_t* O; int ldc; const unsigned long long* ssq;
    __device__ __forceinline__ void operator()(const f32x4 (&acc)[2][2][4][2], const Unit& u, int wr, int wc, int fr, int fq, ssq_lds_t rl) const {
        const int row0 = u.pm * BM + wr * 64 + fr, col0 = u.pn * HALF + wc * 32 + 8 * fq;
        PG8_ROW_RSTD(rs, rl, wr * 64 + fr)
#pragma unroll
        for (int ai = 0; ai < 2; ++ai)
#pragma unroll
            for (int m = 0; m < 4; ++m) {
                bf16_t* rowp = O + (((size_t)u.pm * (ldc >> 6) + 2 * u.pn + (wc >> 1)) * BM + (wr * 64 + fr + ai * HALF + m * 16)) * BK + (wc & 1) * 32 + 8 * fq;
                float h[8];
#pragma unroll
                for (int n = 0; n < 2; ++n)
#pragma unroll
                    for (int j = 0; j < 4; ++j) { const float g = acc[ai][0][m][n][j] * rs[ai][m], up = acc[ai][1][m][n][j] * rs[ai][m]; h[n * 4 + j] = g * fast_sigmoid(g) * up; }
                u32x4 w; w.x = cvt_pk_bf16(h[0], h[1]); w.y = cvt_pk_bf16(h[2], h[3]); w.z = cvt_pk_bf16(h[4], h[5]); w.w = cvt_pk_bf16(h[6], h[7]);
                __builtin_nontemporal_store(w, (u32x4*)rowp);
            }
    }
};
struct EpiRes {
    static constexpr bool PERM = true, AFTER_DRAIN = false, ROWNORM = false;
    const bf16_t* base; bf16_t* out; int ldc; float scale; unsigned long long* ssq_out;
    static constexpr bool HAS_PRE = true;
    struct Pre { u32x4 b[2][4][2]; };
    __device__ __forceinline__ void preload(Pre& P, const Unit& u, int wr, int wc, int fr, int fq) const {
        const int row0 = u.pm * BM + wr * 64 + fr, col0 = u.pn * BM + wc * 32 + 8 * fq;
#pragma unroll
        for (int ai = 0; ai < 2; ++ai)
#pragma unroll
            for (int m = 0; m < 4; ++m)
#pragma unroll
                for (int bj = 0; bj < 2; ++bj) P.b[ai][m][bj] = *(const u32x4*)(base + (size_t)(row0 + ai * HALF + m * 16) * ldc + col0 + bj * HALF);
    }
    __device__ __forceinline__ void operator()(const f32x4 (&acc)[2][2][4][2], const Unit& u, int wr, int wc, int fr, int fq, ssq_lds_t rl, const Pre& P) const {
        const int row0 = u.pm * BM + wr * 64 + fr, col0 = u.pn * BM + wc * 32 + 8 * fq;
        float ss[2][4];
#pragma unroll
        for (int ai = 0; ai < 2; ++ai)
#pragma unroll
            for (int m = 0; m < 4; ++m) {
                const size_t off = (size_t)(row0 + ai * HALF + m * 16) * ldc + col0;
                float sq = 0.f;
#pragma unroll
                for (int bj = 0; bj < 2; ++bj) {
                    const u32x4 bb = P.b[ai][m][bj];
                    const f32x4 a0 = acc[ai][bj][m][0] * scale, a1 = acc[ai][bj][m][1] * scale;
                    float y[8];
#pragma unroll
                    for (int q = 0; q < 4; ++q) { const f32x4 a = q < 2 ? a0 : a1; y[2 * q] = __builtin_bit_cast(float, bb[q] << 16) + a[(q & 1) * 2]; y[2 * q + 1] = __builtin_bit_cast(float, bb[q] & 0xffff0000u) + a[(q & 1) * 2 + 1]; }
#pragma unroll
                    for (int q = 0; q < 8; ++q) sq += y[q] * y[q];
                    u32x4 w; w.x = cvt_pk_bf16(y[0], y[1]); w.y = cvt_pk_bf16(y[2], y[3]); w.z = cvt_pk_bf16(y[4], y[5]); w.w = cvt_pk_bf16(y[6], y[7]);
                    *(u32x4*)(out + off + bj * HALF) = w;
                }
                ss[ai][m] = sq;
            }
#pragma unroll
        for (int ai = 0; ai < 2; ++ai)
#pragma unroll
            for (int m = 0; m < 4; ++m) ss[ai][m] = xor32_sum(xor16_sum(ss[ai][m]));
        if (fq == 0) {
#pragma unroll
            for (int ai = 0; ai < 2; ++ai)
#pragma unroll
                for (int m = 0; m < 4; ++m) atomicAdd(ssq_out + (row0 + ai * HALF + m * 16), (unsigned long long)(unsigned)fminf(ss[ai][m] * SSQ_FIX, 4.0e9f));
        }
    }
};
struct EpiInA {
    static constexpr bool PERM = true, AFTER_DRAIN = false, ROWNORM = true, HAS_PRE = false;
    bf16_t* QKV; size_t sec_stride; const float *cosa, *sina; int seq; const unsigned long long* ssq;
    __device__ __forceinline__ void operator()(const f32x4 (&acc)[2][2][4][2], const Unit& u, int wr, int wc, int fr, int fq, ssq_lds_t rl) const {
        const int sec = u.pn / 6, hp = u.pn - sec * 6;
        bf16_t* O = QKV + (size_t)sec * sec_stride;
        const int row0 = u.pm * BM + wr * 64 + fr, col0 = hp * BM + wc * 32 + 8 * fq;
        const float sc0 = sec == 0 ? 0.08838834764831845f : 1.0f;
        const int i0 = wc * 16 + fq * 4;
        PG8_ROW_RSTD(rs, rl, wr * 64 + fr)
        if (sec < 2) {
#pragma unroll
            for (int ai = 0; ai < 2; ++ai) {
                f32x4 cs[4][2];
#pragma unroll
                for (int m = 0; m < 4; ++m) {
                    const int t = (row0 + ai * HALF + m * 16) % seq;
                    cs[m][0] = *(const f32x4*)(cosa + (size_t)t * 64 + i0); cs[m][1] = *(const f32x4*)(sina + (size_t)t * 64 + i0);
                }
#pragma unroll
                for (int m = 0; m < 4; ++m) {
                    bf16_t* rowp = O + (size_t)(row0 + ai * HALF + m * 16) * 1536 + col0;
                    const float sc = sc0 * rs[ai][m];
                    const f32x4 c = cs[m][0], sn = cs[m][1];
#pragma unroll
                    for (int bj = 0; bj < 2; ++bj) {
                        const f32x4 x1 = acc[ai][bj][m][0], x2 = acc[ai][bj][m][1];
                        const f32x4 y1 = (x1 * c - x2 * sn) * sc, y2 = (x2 * c + x1 * sn) * sc;
                        u32x4 w; w.x = cvt_pk_bf16(y1[0], y1[1]); w.y = cvt_pk_bf16(y1[2], y1[3]); w.z = cvt_pk_bf16(y2[0], y2[1]); w.w = cvt_pk_bf16(y2[2], y2[3]);
                        __builtin_nontemporal_store(w, (u32x4*)(rowp + bj * HALF));
                    }
                }
            }
        } else {
#pragma unroll
            for (int ai = 0; ai < 2; ++ai)
#pragma unroll
                for (int m = 0; m < 4; ++m) {
                    bf16_t* rowp = O + (size_t)(row0 + ai * HALF + m * 16) * 1536 + col0;
                    const float sc = rs[ai][m];
#pragma unroll
                    for (int bj = 0; bj < 2; ++bj) {
                        const f32x4 v0 = acc[ai][bj][m][0] * sc, v1 = acc[ai][bj][m][1] * sc;
                        u32x4 w; w.x = cvt_pk_bf16(v0[0], v0[1]); w.y = cvt_pk_bf16(v0[2], v0[3]); w.z = cvt_pk_bf16(v1[0], v1[1]); w.w = cvt_pk_bf16(v1[2], v1[3]);
                        __builtin_nontemporal_store(w, (u32x4*)(rowp + bj * HALF));
                    }
                }
        }
    }
};
struct EpiInR {
    static constexpr bool PERM = true, AFTER_DRAIN = false, ROWNORM = true, HAS_PRE = false;
    bf16_t* QK; size_t qk_stride; bf16_t* VG; size_t vg_stride; const float *cosr, *sinr; int seq; const unsigned long long* ssq;
    __device__ __forceinline__ void operator()(const f32x4 (&acc)[2][2][4][2], const Unit& u, int wr, int wc, int fr, int fq, ssq_lds_t rl) const {
        const int pn = u.pn;
        const int row0 = u.pm * BM + wr * 64 + fr;
        PG8_ROW_RSTD(rs, rl, wr * 64 + fr)
        if (pn < 16) {
            bf16_t* O = QK + (size_t)(pn >> 3) * qk_stride; const int head = pn & 7; const float sc0 = pn < 8 ? 1.0f : 0.0625f;
            const int col0 = wc * 32 + 8 * fq;
#pragma unroll
            for (int aim = 0; aim < 4; ++aim) {
              const int ai = aim >> 1;
              f32x4 cs[2][2][2];
#pragma unroll
              for (int mm = 0; mm < 2; ++mm) {
                  const int t = (row0 + ai * HALF + ((aim & 1) * 2 + mm) * 16) % seq;
#pragma unroll
                  for (int bj = 0; bj < 2; ++bj) { const int i0 = bj * 64 + wc * 16 + fq * 4; cs[mm][bj][0] = *(const f32x4*)(cosr + (size_t)t * 128 + i0); cs[mm][bj][1] = *(const f32x4*)(sinr + (size_t)t * 128 + i0); }
              }
#pragma unroll
                for (int mm = 0; mm < 2; ++mm) {
                    const int m = (aim & 1) * 2 + mm;
                    const int row = row0 + ai * HALF + m * 16; const int bb = row / seq, t = row - bb * seq;
                    bf16_t* rowp = O + ((size_t)(bb * 8 + head) * seq + t) * 256 + col0;
                    if (pn < 8) rowp = O + ((size_t)(bb * 8 + head) * seq + (t - fr)) * 256 + wc * 512 + (16 * fq + fr) * 8;
                    const float sc = sc0 * rs[ai][m];
#pragma unroll
                    for (int bj = 0; bj < 2; ++bj) {
                        const f32x4 c = cs[mm][bj][0], s = cs[mm][bj][1];
                        const f32x4 x1 = acc[ai][bj][m][0], x2 = acc[ai][bj][m][1];
                        const f32x4 y1 = (x1 * c - x2 * s) * sc, y2 = (x2 * c + x1 * s) * sc;
                        u32x4 w; w.x = cvt_pk_bf16(y1[0], y1[1]); w.y = cvt_pk_bf16(y1[2], y1[3]); w.z = cvt_pk_bf16(y2[0], y2[1]); w.w = cvt_pk_bf16(y2[2], y2[3]);
                        __builtin_nontemporal_store(w, (u32x4*)(rowp + bj * (pn < 8 ? 4 * 512 : HALF)));
                    }
                }
            }
        } else {
            const int ct = pn - 16, head = ct >> 1;
#pragma unroll
            for (int ai = 0; ai < 2; ++ai)
#pragma unroll
                for (int m = 0; m < 4; ++m) {
                    const int row = row0 + ai * HALF + m * 16; const int bb = row / seq, t = row - bb * seq;
#pragma unroll
                    for (int bj = 0; bj < 2; ++bj) {
                        const int sl = (ct & 1) * 8 + bj * 4 + wc;
                        bf16_t* p = VG + (((size_t)(bb * 8 + head) * 16 + sl) * seq + t) * 32 + 8 * fq;
                        const f32x4 v0 = acc[ai][bj][m][0] * rs[ai][m], v1 = acc[ai][bj][m][1] * rs[ai][m];
                        u32x4 w; w.x = cvt_pk_bf16(v0[0], v0[1]); w.y = cvt_pk_bf16(v0[2], v0[3]); w.z = cvt_pk_bf16(v1[0], v1[1]); w.w = cvt_pk_bf16(v1[2], v1[3]);
                        __builtin_nontemporal_store(w, (u32x4*)p);
                    }
                }
        }
    }
};
struct EpiGates {
    static constexpr bool PERM = true, AFTER_DRAIN = false, ROWNORM = true, HAS_PRE = false;
    bf16_t* GAB; size_t g_stride; const unsigned long long* ssq;
    __device__ __forceinline__ void operator()(const f32x4 (&acc)[2][2][4][2], const Unit& u, int wr, int wc, int fr, int fq, ssq_lds_t rl) const {
        bf16_t* O = GAB + (size_t)(u.pn >> 3) * g_stride; const int ct = u.pn & 7;
        const int row0 = u.pm * BM + wr * 64 + fr, col0 = ct * BM + wc * 32 + 8 * fq;
        PG8_ROW_RSTD(rs, rl, wr * 64 + fr)
#pragma unroll
        for (int ai = 0; ai < 2; ++ai)
#pragma unroll
            for (int m = 0; m < 4; ++m) {
                bf16_t* rowp = O + (size_t)(row0 + ai * HALF + m * 16) * 2048 + col0;
#pragma unroll
                for (int bj = 0; bj < 2; ++bj) {
                    f32x4 v0 = acc[ai][bj][m][0] * rs[ai][m], v1 = acc[ai][bj][m][1] * rs[ai][m];
#pragma unroll
                    for (int j = 0; j < 4; ++j) { v0[j] = fast_sigmoid(v0[j]); v1[j] = fast_sigmoid(v1[j]); }
                    u32x4 w; w.x = cvt_pk_bf16(v0[0], v0[1]); w.y = cvt_pk_bf16(v0[2], v0[3]); w.z = cvt_pk_bf16(v1[0], v1[1]); w.w = cvt_pk_bf16(v1[2], v1[3]);
                    __builtin_nontemporal_store(w, (u32x4*)(rowp + bj * HALF));
                }
            }
    }
};
struct EpiG {
    static constexpr bool PERM = true, AFTER_DRAIN = false, ROWNORM = true, HAS_PRE = false;
    static constexpr int seq = 16384;
    const bf16_t* OP; bf16_t* O; const float* st; const unsigned long long* ssq;
    __device__ __forceinline__ void operator()(const f32x4 (&acc)[2][2][4][2], const Unit& u, int wr, int wc, int fr, int fq, ssq_lds_t rl) const {
        const int pn = u.pn, head = pn >> 1;
        const int row0 = u.pm * BM + wr * 64 + fr;
        PG8_ROW_RSTD(rs, rl, wr * 64 + fr)
#pragma unroll
        for (int ai = 0; ai < 2; ++ai) {
            u32x4 ov[4][2]; f32x2_t sv[4];
#pragma unroll
            for (int mm = 0; mm < 4; ++mm) {
                const int row = row0 + ai * HALF + mm * 16; const int bb = row / seq, t = row - bb * seq;
                sv[mm] = *(const f32x2_t*)(st + ((size_t)row * 8 + head) * 2);
#pragma unroll
                for (int bj = 0; bj < 2; ++bj) { const int sl = (pn & 1) * 8 + bj * 4 + wc; ov[mm][bj] = *(const u32x4*)(OP + (((size_t)(bb * 8 + head) * 16 + sl) * seq + t) * 32 + 8 * fq); }
            }
#pragma unroll
            for (int mm = 0; mm < 4; ++mm) {
                const int m = mm;
                bf16_t* rowp = O + (size_t)(row0 + ai * HALF + m * 16) * 4096 + pn * BM + wc * 32 + 8 * fq;
                const float r = rs[ai][m], mu = sv[mm].x, rg = sv[mm].y;
#pragma unroll
                for (int bj = 0; bj < 2; ++bj) {
                    float y[8];
#pragma unroll
                    for (int q = 0; q < 4; ++q) {
                        const int n = q >> 1, j = (q & 1) * 2;
                        const float g0 = acc[ai][bj][m][n][j] * r, g1 = acc[ai][bj][m][n][j + 1] * r;
                        const float o0 = __builtin_bit_cast(float, ov[mm][bj][q] << 16), o1 = __builtin_bit_cast(float, ov[mm][bj][q] & 0xffff0000u);
                        y[2 * q] = (o0 - mu) * rg * (g0 * fast_sigmoid(g0)); y[2 * q + 1] = (o1 - mu) * rg * (g1 * fast_sigmoid(g1));
                    }
                    u32x4 w; w.x = cvt_pk_bf16(y[0], y[1]); w.y = cvt_pk_bf16(y[2], y[3]); w.z = cvt_pk_bf16(y[4], y[5]); w.w = cvt_pk_bf16(y[6], y[7]);
                    __builtin_nontemporal_store(w, (u32x4*)(rowp + bj * HALF));
                }
            }
        }
    }
};
struct EpiGated {
    static constexpr bool PERM = true, AFTER_DRAIN = false, ROWNORM = false, HAS_PRE = false;
    const bf16_t* gate; const bf16_t* add; bf16_t* out; int ldc;
    __device__ __forceinline__ void operator()(const f32x4 (&acc)[2][2][4][2], const Unit& u, int wr, int wc, int fr, int fq, ssq_lds_t rl) const {
        const int row0 = u.pm * BM + wr * 64 + fr, col0 = u.pn * BM + wc * 32 + 8 * fq;
#pragma unroll
        for (int ai = 0; ai < 2; ++ai) {
            u32x4 gv[4][2], av[4][2];
#pragma unroll
            for (int m = 0; m < 4; ++m)
#pragma unroll
                for (int bj = 0; bj < 2; ++bj) gv[m][bj] = *(const u32x4*)(gate + (size_t)(row0 + ai * HALF + m * 16) * ldc + col0 + bj * HALF);
            if (add) {
#pragma unroll
                for (int m = 0; m < 4; ++m)
#pragma unroll
                    for (int bj = 0; bj < 2; ++bj) av[m][bj] = *(const u32x4*)(add + (size_t)(row0 + ai * HALF + m * 16) * ldc + col0 + bj * HALF);
            } else {
#pragma unroll
                for (int m = 0; m < 4; ++m)
#pragma unroll
                    for (int bj = 0; bj < 2; ++bj) av[m][bj] = (u32x4){0u, 0u, 0u, 0u};
            }
#pragma unroll
            for (int m = 0; m < 4; ++m) {
                const size_t off = (size_t)(row0 + ai * HALF + m * 16) * ldc + col0;
#pragma unroll
                for (int bj = 0; bj < 2; ++bj) {
                    float r[8];
#pragma unroll
                    for (int q = 0; q < 4; ++q) {
                        const float g0 = __builtin_bit_cast(float, gv[m][bj][q] << 16), g1 = __builtin_bit_cast(float, gv[m][bj][q] & 0xffff0000u);
                        const float a0 = __builtin_bit_cast(float, av[m][bj][q] << 16), a1 = __builtin_bit_cast(float, av[m][bj][q] & 0xffff0000u);
                        const int n = q >> 1, j = (q & 1) * 2;
                        r[2 * q] = a0 + g0 * acc[ai][bj][m][n][j]; r[2 * q + 1] = a1 + g1 * acc[ai][bj][m][n][j + 1];
                    }
                    u32x4 w; w.x = cvt_pk_bf16(r[0], r[1]); w.y = cvt_pk_bf16(r[2], r[3]); w.z = cvt_pk_bf16(r[4], r[5]); w.w = cvt_pk_bf16(r[6], r[7]);
                    *(u32x4*)(out + off + bj * HALF) = w;
                }
            }
        }
    }
};

template <class Epi, class Sched, bool ALIGN_EPI = true, bool SP2 = true>
__device__ __forceinline__ void gemm_phase(PG8_LAS unsigned char* lds, const int tid, const Gemm g, const Sched& S, const Epi& E) {
    const int wid = __builtin_amdgcn_readfirstlane(tid >> 6), lane = tid & 63, wr = wid >> 2, wc = wid & 3, fr = lane & 15, fq = lane >> 4;
    const int K = g.K, nt = K / BK;
    unsigned voffA[2], voffB[2];
#pragma unroll
    for (int i = 0; i < 2; ++i) { int R, C; stage_rc(tid * 16 + i * 8192, R, C); const int Rb = Epi::PERM ? ((R & ~31) + perm32(R & 31)) : R;
        voffA[i] = (unsigned)(R * (g.a_tiled ? BK : K) + C) * 2u; voffB[i] = (unsigned)(Rb * BK + C) * 2u; }
    const size_t kstep = (size_t)(BK * 2);
    const size_t hstep = (size_t)HALF * K * 2;
    const size_t tstep = 2 * hstep;
    const size_t kstepB = (size_t)BM * BK * 2, hstepB = (size_t)HALF * BK * 2;
    const size_t kstepA = g.a_tiled ? (size_t)BM * BK * 2 : kstep, hstepA = g.a_tiled ? (size_t)HALF * BK * 2 : hstep;
    const unsigned ldsw = (unsigned)wid * 1024u;
    const int aoff = lds_byte(wr * 64 + fr, fq * 8), boff = lds_byte(wc * 32 + fr, fq * 8);
#define PG8_SA(b, h) (((b) * 2 + (h)) * HTB)
#define PG8_SB(b, h) ((4 + (b) * 2 + (h)) * HTB)
#define PG8_STAGE(bufoff, gbase, voff) do { _Pragma("unroll") for (int _i = 0; _i < 2; ++_i) \
        __builtin_amdgcn_global_load_lds((const unsigned*)((const char*)(gbase) + (voff)[_i]), (PG8_LAS unsigned*)(lds + (bufoff) + ldsw + _i * 8192), 16, 0, 0); } while (0)
#define PG8_LDA(dst, b, h) do { _Pragma("unroll") for (int m = 0; m < 4; ++m) _Pragma("unroll") for (int k = 0; k < 2; ++k) dst[m][k] = *(const PG8_LAS bf16x8*)(lds + PG8_SA(b, h) + aoff + m * 2048 + k * 1024); } while (0)
#define PG8_LDB(dst, b, h) do { _Pragma("unroll") for (int n = 0; n < 2; ++n) _Pragma("unroll") for (int k = 0; k < 2; ++k) dst[n][k] = *(const PG8_LAS bf16x8*)(lds + PG8_SB(b, h) + boff + n * 2048 + k * 1024); } while (0)
#define PG8_MMA(ai, bj, At, Bt) do { __builtin_amdgcn_s_setprio(1); _Pragma("unroll") for (int m = 0; m < 4; ++m) _Pragma("unroll") for (int n = 0; n < 2; ++n) _Pragma("unroll") for (int k = 0; k < 2; ++k) \
        acc[ai][bj][m][n] = __builtin_amdgcn_mfma_f32_16x16x32_bf16(Bt[n][k], At[m][k], acc[ai][bj][m][n], 0, 0, 0); __builtin_amdgcn_s_setprio(0); } while (0)
#define PG8_WAIT_V(n) asm volatile("s_waitcnt vmcnt(" #n ")" ::: "memory")
#define PG8_WAIT_L(n) asm volatile("s_waitcnt lgkmcnt(" #n ")" ::: "memory")
#define PG8_BAR __builtin_amdgcn_s_barrier()
#define PG8_SCHED __builtin_amdgcn_sched_barrier(0)
    Unit cur, nxt; int ui = 0;
    if (!S.next(0, cur)) return;
    f32x4 acc[2][2][4][2];
#pragma unroll
    for (int a = 0; a < 2; ++a)
#pragma unroll
        for (int b = 0; b < 2; ++b)
#pragma unroll
            for (int m = 0; m < 4; ++m)
#pragma unroll
                for (int n = 0; n < 2; ++n) { f64x2_t z; asm volatile("v_mov_b64 %0, 0" : "=v"(z.x)); asm volatile("v_mov_b64 %0, 0" : "=v"(z.y)); acc[a][b][m][n] = __builtin_bit_cast(f32x4, z); }
    bf16x8 At[4][2], B0[2][2], B1[2][2];
    const char* cA = (const char*)g.A + (size_t)cur.pm * tstep; const char* cB = (const char*)g.Bt + (size_t)cur.pn * tstep;
    S.a_ready(cur);
    if constexpr (SP2) {
        PG8_STAGE(PG8_SB(0, 0), cB, voffB); PG8_STAGE(PG8_SB(0, 1), cB + hstepB, voffB); PG8_STAGE(PG8_SA(0, 0), cA, voffA); PG8_STAGE(PG8_SA(0, 1), cA + hstepA, voffA);
        if (wr == 1) PG8_BAR;
        PG8_WAIT_V(2); PG8_BAR;
        PG8_STAGE(PG8_SB(1, 0), cB + kstepB, voffB); PG8_STAGE(PG8_SA(1, 0), cA + kstepA, voffA); PG8_STAGE(PG8_SB(1, 1), cB + hstepB + kstepB, voffB);
        PG8_WAIT_V(6); PG8_BAR;
    } else {
        PG8_STAGE(PG8_SB(0, 0), cB, voffB); PG8_STAGE(PG8_SA(0, 0), cA, voffA); PG8_STAGE(PG8_SB(0, 1), cB + hstepB, voffB); PG8_STAGE(PG8_SA(0, 1), cA + hstepA, voffA);
        if (wr == 1) PG8_BAR;
        PG8_WAIT_V(4); PG8_BAR;
        PG8_STAGE(PG8_SB(1, 0), cB + kstepB, voffB); PG8_STAGE(PG8_SA(1, 0), cA + kstepA, voffA); PG8_STAGE(PG8_SB(1, 1), cB + hstepB + kstepB, voffB);
        PG8_WAIT_V(6); PG8_BAR;
    }
    for (;;) {
        const bool has_next = S.next(ui + 1, nxt);
        const char* nA = has_next ? (const char*)g.A + (size_t)nxt.pm * tstep : cA; const char* nB = has_next ? (const char*)g.Bt + (size_t)nxt.pn * tstep : cB;
        if constexpr (Epi::ROWNORM) __builtin_amdgcn_global_load_lds((const unsigned*)(E.ssq + (size_t)cur.pm * BM) + wid * 64 + lane, (PG8_LAS unsigned*)(lds + SSQ_LDS_OFF + (ui & 1) * 2048 + wid * 256), 4, 0, 0);
        for (int t = 0; t < nt; t += 2) {
            const bool last = (t == nt - 2);
            const char* a1 = cA + (size_t)(t + 1) * kstepA;
            const char* a2 = last ? nA : cA + (size_t)(t + 2) * kstepA; const char* b2 = last ? nB : cB + (size_t)(t + 2) * kstepB;
            const char* a3 = a2 + kstepA; const char* b3 = b2 + kstepB;
            if (last && has_next) S.a_ready(nxt);
            if constexpr (SP2) {
            PG8_LDB(B0, 0, 0); PG8_LDB(B1, 0, 1); PG8_SCHED; PG8_LDA(At, 0, 0); PG8_STAGE(PG8_SA(1, 1), a1 + hstepA, voffA);
            PG8_WAIT_V(8); PG8_WAIT_L(0); PG8_BAR; PG8_MMA(0, 0, At, B0); PG8_MMA(0, 1, At, B1); PG8_BAR; PG8_SCHED;
            PG8_LDA(At, 0, 1); PG8_STAGE(PG8_SB(0, 0), b2, voffB); PG8_STAGE(PG8_SB(0, 1), b2 + hstepB, voffB); PG8_STAGE(PG8_SA(0, 0), a2, voffA);
            PG8_WAIT_V(8); PG8_WAIT_L(0); PG8_BAR; PG8_MMA(1, 0, At, B0); PG8_MMA(1, 1, At, B1); PG8_BAR; PG8_SCHED;
            PG8_LDB(B0, 1, 0); PG8_LDB(B1, 1, 1); PG8_SCHED; PG8_LDA(At, 1, 0); PG8_STAGE(PG8_SA(0, 1), a2 + hstepA, voffA);
            PG8_WAIT_V(8); PG8_WAIT_L(0); PG8_BAR; PG8_MMA(0, 0, At, B0); PG8_MMA(0, 1, At, B1); PG8_BAR; PG8_SCHED;
            PG8_LDA(At, 1, 1); PG8_STAGE(PG8_SB(1, 0), b3, voffB); PG8_STAGE(PG8_SB(1, 1), b3 + hstepB, voffB); PG8_STAGE(PG8_SA(1, 0), a3, voffA);
            PG8_WAIT_V(8); PG8_WAIT_L(0); PG8_BAR; PG8_MMA(1, 0, At, B0); PG8_MMA(1, 1, At, B1); PG8_BAR; PG8_SCHED;
            } else {
            PG8_LDB(B0, 0, 0); PG8_SCHED; PG8_LDA(At, 0, 0); PG8_STAGE(PG8_SA(1, 1), a1 + hstepA, voffA);
            PG8_WAIT_L(8); PG8_BAR; PG8_WAIT_L(0); PG8_MMA(0, 0, At, B0); PG8_BAR; PG8_SCHED;
            PG8_LDB(B1, 0, 1); PG8_STAGE(PG8_SB(0, 0), b2, voffB);
            PG8_BAR; PG8_WAIT_L(0); PG8_MMA(0, 1, At, B1); PG8_BAR;
            PG8_LDA(At, 0, 1); PG8_STAGE(PG8_SA(0, 0), a2, voffA);
            PG8_BAR; PG8_WAIT_L(0); PG8_MMA(1, 0, At, B0); PG8_BAR; PG8_SCHED;
            PG8_STAGE(PG8_SB(0, 1), b2 + hstepB, voffB);
            PG8_WAIT_V(6); PG8_BAR; PG8_MMA(1, 1, At, B1); PG8_BAR;
            PG8_LDB(B0, 1, 0); PG8_SCHED; PG8_LDA(At, 1, 0); PG8_STAGE(PG8_SA(0, 1), a2 + hstepA, voffA);
            PG8_WAIT_L(8); PG8_BAR; PG8_WAIT_L(0); PG8_MMA(0, 0, At, B0); PG8_BAR; PG8_SCHED;
            PG8_LDB(B1, 1, 1); PG8_STAGE(PG8_SB(1, 0), b3, voffB);
            PG8_BAR; PG8_WAIT_L(0); PG8_MMA(0, 1, At, B1); PG8_BAR;
            PG8_LDA(At, 1, 1); PG8_STAGE(PG8_SA(1, 0), a3, voffA);
            PG8_BAR; PG8_WAIT_L(0); PG8_MMA(1, 0, At, B0); PG8_BAR; PG8_SCHED;
            PG8_STAGE(PG8_SB(1, 1), b3 + hstepB, voffB);
            PG8_WAIT_V(6); PG8_BAR; PG8_MMA(1, 1, At, B1); PG8_BAR;
            }
        }
        if constexpr (Epi::HAS_PRE) {
            typename Epi::Pre pre; E.preload(pre, cur, wr, wc, fr, fq);
            if constexpr (ALIGN_EPI) { if (wr == 0) PG8_BAR; }
            E(acc, cur, wr, wc, fr, fq, (ssq_lds_t)(lds + SSQ_LDS_OFF + (ui & 1) * 2048), pre); S.done(cur);
        } else {
            if constexpr (ALIGN_EPI) { if (wr == 0) PG8_BAR; }
            if constexpr (!Epi::AFTER_DRAIN) { E(acc, cur, wr, wc, fr, fq, (ssq_lds_t)(lds + SSQ_LDS_OFF + (ui & 1) * 2048)); S.done(cur); }
        }
        if (!has_next) break;
#pragma unroll
        for (int a = 0; a < 2; ++a)
#pragma unroll
            for (int b = 0; b < 2; ++b)
#pragma unroll
                for (int m = 0; m < 4; ++m)
#pragma unroll
                    for (int n = 0; n < 2; ++n) { f64x2_t z; asm volatile("v_mov_b64 %0, 0" : "=v"(z.x)); asm volatile("v_mov_b64 %0, 0" : "=v"(z.y)); acc[a][b][m][n] = __builtin_bit_cast(f32x4, z); }
        cur = nxt; cA = nA; cB = nB; ++ui;
        if constexpr (ALIGN_EPI) { if (wr == 1) PG8_BAR; }
    }
    PG8_WAIT_V(0);
    if constexpr (!ALIGN_EPI) { if (wr == 0) PG8_BAR; }
    PG8_BAR;
#undef PG8_SA
#undef PG8_SB
#undef PG8_STAGE
#undef PG8_LDA
#undef PG8_LDB
#undef PG8_MMA
#undef PG8_WAIT_V
#undef PG8_WAIT_L
#undef PG8_BAR
#undef PG8_SCHED
}
}

constexpr int NWAVES = 8;
constexpr int BATCH = 2, SEQ = 16384, D = 2048, DEPTH = 2, FF = 5632;
constexpr int M = BATCH * SEQ;
constexpr int AW = 1536, AOW = 512;
constexpr int RQK = 2048, RV = 4096;
constexpr int INC = 20992;
constexpr float RMS_EPS = 1e-6f, GN_EPS = 1e-5f;
constexpr float LOG2E = 1.44269504089f;

constexpr size_t MiB = 1u << 20;
constexpr size_t WS_CTL = 0, CTL_ZERO_BYTES = 1 * MiB;
constexpr size_t WS_COSA = 1 * MiB, WS_SINA = 5 * MiB, WS_COSR = 9 * MiB, WS_SINR = 17 * MiB;
constexpr size_t WS_SSQ = 29 * MiB, SSQ_BYTES = (size_t)32768 * 8;
constexpr size_t WS_MLM = 25 * MiB, WS_MLL = 27 * MiB, WS_GST = 25 * MiB;
constexpr size_t WS_WGU1 = 32 * MiB, WS_WD1 = 76 * MiB, WS_WIN = 98 * MiB, WS_WPA = 180 * MiB, WS_WPR = 182 * MiB, WS_WOUT = 198 * MiB, WS_WGU2 = 206 * MiB, WS_WD2 = 250 * MiB;
constexpr size_t WS_H = 272 * MiB;
constexpr size_t WS_R = 400 * MiB;
constexpr size_t WS_HID = WS_R;
constexpr size_t WS_QA = WS_R, WS_KA = WS_R + 96 * MiB, WS_VA = WS_R + 192 * MiB, WS_OG = 1184 * MiB;
constexpr size_t WS_QR = WS_R, WS_KR = WS_R + 128 * MiB, WS_VR = WS_R + 256 * MiB, WS_OR = WS_R + 512 * MiB;
constexpr size_t WS_PR = WS_R + 768 * MiB;
constexpr size_t WS_SGA = WS_R, WS_SGB = WS_R + 128 * MiB;
constexpr size_t WS_OA = 1280 * MiB;
constexpr size_t WS_END = 1312 * MiB;
static_assert(WS_PR == WS_OR + 256 * MiB && WS_PR + 64 * MiB <= WS_OA && WS_VA - WS_KA == WS_KA - WS_QA && WS_OR + 256 * MiB <= WS_OA && WS_OG + 96 * MiB <= WS_OA && WS_OG >= WS_OR + 256 * MiB && WS_HID + 352 * MiB <= WS_OA, "ws map");
constexpr int CW_TMO = 0;
constexpr int CW_BAR = 4096;

constexpr int RING_BYTES = 131072;
constexpr int LDSCTL_OFF = 143360, MISC_OFF = LDSCTL_OFF + 320;
constexpr int LDS_BYTES = 147456;

#define GAS __attribute__((address_space(1)))
#define LAS __attribute__((address_space(3)))
typedef unsigned short bf16;
typedef unsigned v4u __attribute__((ext_vector_type(4)));
typedef unsigned v2u __attribute__((ext_vector_type(2)));
typedef float f32x4 __attribute__((ext_vector_type(4)));
typedef short bf16x8 __attribute__((ext_vector_type(8)));
typedef GAS unsigned gu32;
#define RLX_AGENT __ATOMIC_RELAXED, __HIP_MEMORY_SCOPE_AGENT
#define LDS_WAIT() asm volatile("s_waitcnt lgkmcnt(0)" ::: "memory")
#define VM_WAIT() asm volatile("s_waitcnt vmcnt(0)" ::: "memory")
__device__ __forceinline__ unsigned f2bf(float f) { unsigned u = __builtin_bit_cast(unsigned, f); return (u + 0x7fffu + ((u >> 16) & 1u)) >> 16; }
__device__ __forceinline__ unsigned pk2(float lo, float hi) { return f2bf(lo) | (f2bf(hi) << 16); }
__device__ __forceinline__ float bf_lo(unsigned w) { return __uint_as_float(w << 16); }
__device__ __forceinline__ float bf_hi(unsigned w) { return __uint_as_float(w & 0xffff0000u); }

#define XB_TMO      128
#define XB_XCNT(j)  (256  + 64 * (j))
#define XB_XSUB(j)  (1280 + 64 * (j))
#define XB_XGEN(j)  (2304 + 64 * (j))
#define XB_TOP      3328
#define XB_TOPGEN   3392
#define XCD_BAR_WORDS 3456
#define XB_SPIN_CAP (1u << 18)

__device__ __forceinline__ unsigned xb_ld(unsigned* p)              { return __hip_atomic_load(p, __ATOMIC_RELAXED, __HIP_MEMORY_SCOPE_AGENT); }
__device__ __forceinline__ unsigned xb_add(unsigned* p, unsigned v) { return __hip_atomic_fetch_add(p, v, __ATOMIC_RELAXED, __HIP_MEMORY_SCOPE_AGENT); }
__device__ __forceinline__ unsigned xb_xcc_id() { return (unsigned)__builtin_amdgcn_s_getreg((3 << 11) | 20) & 0xFu; }
#define XB_SPIN(cond, bar) do { unsigned _sp = 0; while (cond) { __builtin_amdgcn_s_sleep(1); \
    if ((++_sp & 255u) == 0u) { if (xb_ld(&(bar)[XB_TMO])) break; if (_sp > XB_SPIN_CAP) { atomicAdd(&(bar)[XB_TMO], 1u); break; } } } } while (0)

struct XcdBarrier {
    unsigned* bar; unsigned x;
    volatile LAS unsigned* st;
};
__device__ __forceinline__ XcdBarrier xcd_barrier_post(unsigned* bar, volatile LAS unsigned* st) {
    XcdBarrier b; b.bar = bar; b.x = xb_xcc_id(); b.st = st;
    if (threadIdx.x == 0) (void)xb_add(&bar[XB_XCNT(b.x)], 1u);
    return b;
}
__device__ __forceinline__ void xcd_barrier_complete(unsigned* bar, unsigned x, unsigned& nloc, unsigned& nx) {
    const unsigned G = gridDim.x * gridDim.y * gridDim.z;
    unsigned sum, cnt, mine, sp = 0u;
    for (;;) {
        sum = 0u; cnt = 0u; mine = 0u;
#pragma unroll
        for (unsigned j = 0; j < 16; ++j) { const unsigned c = xb_ld(&bar[XB_XCNT(j)]); sum += c; cnt += (c > 0u) ? 1u : 0u; mine = (j == x) ? c : mine; }
        if (sum == G) break;
        __builtin_amdgcn_s_sleep(1);
        if ((++sp & 255u) == 0u) { if (xb_ld(&bar[XB_TMO])) break; if (sp > XB_SPIN_CAP) { atomicAdd(&bar[XB_TMO], 1u); break; } }
    }
    nloc = mine > 0u ? mine : 1u; nx = cnt > 0u ? cnt : 1u;
}
__device__ __forceinline__ void xcd_barrier(const XcdBarrier& b) {
    asm volatile("s_waitcnt vmcnt(0)" ::: "memory");
    __syncthreads();
    if (threadIdx.x == 0) {
        unsigned* bar = b.bar;
        __builtin_amdgcn_s_waitcnt(0);
        unsigned nloc = b.st[0], nx = b.st[1];
        if (nloc == 0u) { xcd_barrier_complete(bar, b.x, nloc, nx); b.st[0] = nloc; b.st[1] = nx; }
        const unsigned old = xb_add(&bar[XB_XSUB(b.x)], 1u);
        const unsigned gen = old / nloc;
        if (old + 1u == (gen + 1u) * nloc) {
            __builtin_amdgcn_fence(__ATOMIC_RELEASE, "agent");
            asm volatile("s_waitcnt vmcnt(0)" ::: "memory");
            const unsigned og = xb_add(&bar[XB_TOP], 1u);
            const unsigned tg = og / nx;
            if (og + 1u == (tg + 1u) * nx) xb_add(&bar[XB_TOPGEN], 1u);
            else XB_SPIN(xb_ld(&bar[XB_TOPGEN]) == tg, bar);
            __builtin_amdgcn_fence(__ATOMIC_ACQUIRE, "agent");
            xb_add(&bar[XB_XGEN(b.x)], 1u);
            asm volatile("s_waitcnt vmcnt(0)" ::: "memory");
        } else {
            XB_SPIN(xb_ld(&bar[XB_XGEN(b.x)]) == gen, bar);
            __builtin_amdgcn_fence(__ATOMIC_ACQUIRE, "agent");
            asm volatile("s_waitcnt vmcnt(0)" ::: "memory");
        }
    }
    __syncthreads();
}

struct Frame {
    LAS unsigned char* lds;
    int tid, lane, wave;
    int vcu, G, bx;
    unsigned char* ws;
};
template <int CTRL> __device__ __forceinline__ float dpp_get(float v) { return __builtin_bit_cast(float, __builtin_amdgcn_update_dpp(0, __builtin_bit_cast(int, v), CTRL, 0xf, 0xf, true)); }
__device__ __forceinline__ float wave_sum(float v) {
    v += dpp_get<0xB1>(v); v += dpp_get<0x4E>(v); v += dpp_get<0x141>(v); v += dpp_get<0x140>(v);
    return pg8::xor32_sum(pg8::xor16_sum(v));
}

struct ConvItem { const float* W; const float* gn; bf16* WT; int K, Nsrc, dst_row0, k0, srccol; };
__device__ __forceinline__ void conv_load(const ConvItem& I, int lane, float (&wv)[32], f32x4& g0, f32x4& g1) {
#pragma unroll
    for (int i = 0; i < 32; ++i) wv[i] = I.W[(size_t)(I.k0 + 2 * i + (lane >> 5)) * I.Nsrc + I.srccol];
    g0 = (f32x4){1.f, 1.f, 1.f, 1.f}; g1 = g0;
    if (I.gn) { g0 = *(const f32x4*)(I.gn + I.k0 + 8 * (lane & 7)); g1 = *(const f32x4*)(I.gn + I.k0 + 8 * (lane & 7) + 4); }
}
__device__ __forceinline__ void conv_to_lds(const float (&wv)[32], LAS float* scr, int lane) {
#pragma unroll
    for (int i = 0; i < 32; ++i) scr[(2 * i + (lane >> 5)) * 33 + (lane & 31)] = wv[i];
    LDS_WAIT(); asm volatile("" ::: "memory");
}
__device__ __forceinline__ void conv_store(const ConvItem& I, const LAS float* scr, int lane, f32x4 g0, f32x4 g1) {
    const int c = lane & 7;
#pragma unroll
    for (int j = 0; j < 4; ++j) { const int n = (lane >> 3) + 8 * j; const LAS float* s = scr + (8 * c) * 33 + n;
        v4u o; o.x = pk2(s[0 * 33] * g0.x, s[1 * 33] * g0.y); o.y = pk2(s[2 * 33] * g0.z, s[3 * 33] * g0.w); o.z = pk2(s[4 * 33] * g1.x, s[5 * 33] * g1.y); o.w = pk2(s[6 * 33] * g1.z, s[7 * 33] * g1.w);
        const int row = I.dst_row0 + n;
        *(GAS v4u*)(I.WT + (((size_t)(row >> 8) * (I.K >> 6) + (I.k0 >> 6)) * 256 + (row & 255)) * 64 + 8 * c) = o; }
    LDS_WAIT(); asm volatile("" ::: "memory");
}
__device__ __forceinline__ int win_src_col(int r) {
    if (r < 3072) { const int sec = r / 1536, rr = r - sec * 1536, head = rr >> 7, p = rr & 127; const int wc = p >> 5, fq = (p >> 3) & 3, n = (p >> 2) & 1, j = p & 3; const int i = wc * 16 + fq * 4 + j; return sec * 1536 + head * 128 + n * 64 + i; }
    if (r < 4608) return r;
    if (r < 8704) { int rr = r - 4608; const int sec = rr >> 11; rr &= 2047; const int head = rr >> 8, p = rr & 255; const int bj = p >> 7, wc = (p >> 5) & 3, fq = (p >> 3) & 3, n = (p >> 2) & 1, j = p & 3; const int i = bj * 64 + wc * 16 + fq * 4 + j; return 4608 + sec * 2048 + head * 256 + n * 128 + i; }
    return r;
}
struct LayerW { const float *g1, *u1, *d1, *win, *pa, *pr, *wo, *g2, *u2, *d2, *n1, *nm, *n2; };
__device__ __forceinline__ ConvItem conv_decode(const Frame& F, const LayerW& L, int it) {
    constexpr int I_GU = (D / 64) * (FF / 32), I_D = (FF / 64) * (D / 32), I_IN = (D / 64) * (INC / 32), I_PA = (AOW / 64) * (D / 32), I_PR = (RV / 64) * (D / 32), I_WO = (D / 64) * (D / 32);
    int r = it; const float* W; const float* gn = nullptr; int K, Nsrc, nblk, mode; bf16* WT;
    if (r < I_GU) { W = L.g1; gn = L.n1; K = D; Nsrc = FF; nblk = FF / 32; mode = 1; WT = (bf16*)(F.ws + WS_WGU1); }
    else if ((r -= I_GU) < I_GU) { W = L.u1; gn = L.n1; K = D; Nsrc = FF; nblk = FF / 32; mode = 2; WT = (bf16*)(F.ws + WS_WGU1); }
    else if ((r -= I_GU) < I_D) { W = L.d1; K = FF; Nsrc = D; nblk = D / 32; mode = 0; WT = (bf16*)(F.ws + WS_WD1); }
    else if ((r -= I_D) < I_IN) { W = L.win; gn = L.nm; K = D; Nsrc = INC; nblk = INC / 32; mode = 3; WT = (bf16*)(F.ws + WS_WIN); }
    else if ((r -= I_IN) < I_PA) { W = L.pa; K = AOW; Nsrc = D; nblk = D / 32; mode = 0; WT = (bf16*)(F.ws + WS_WPA); }
    else if ((r -= I_PA) < I_PR) { W = L.pr; K = RV; Nsrc = D; nblk = D / 32; mode = 0; WT = (bf16*)(F.ws + WS_WPR); }
    else if ((r -= I_PR) < I_WO) { W = L.wo; K = D; Nsrc = D; nblk = D / 32; mode = 0; WT = (bf16*)(F.ws + WS_WOUT); }
    else if ((r -= I_WO) < I_GU) { W = L.g2; gn = L.n2; K = D; Nsrc = FF; nblk = FF / 32; mode = 1; WT = (bf16*)(F.ws + WS_WGU2); }
    else if ((r -= I_GU) < I_GU) { W = L.u2; gn = L.n2; K = D; Nsrc = FF; nblk = FF / 32; mode = 2; WT = (bf16*)(F.ws + WS_WGU2); }
    else { r -= I_GU; W = L.d2; K = FF; Nsrc = D; nblk = D / 32; mode = 0; WT = (bf16*)(F.ws + WS_WD2); }
    const int kb = r / nblk, nb = r - kb * nblk;
    int dst_row0 = 32 * nb, srccol = 32 * nb + (F.lane & 31);
    if (mode == 1 || mode == 2) dst_row0 = 256 * (nb >> 2) + 32 * (nb & 3) + (mode == 2 ? 128 : 0);
    if (mode == 3) srccol = win_src_col(32 * nb + (F.lane & 31));
    ConvItem I{W, gn, WT, K, Nsrc, dst_row0, 64 * kb, srccol};
    return I;
}
__device__ __forceinline__ void sincos_f32arg(float ang, float& s_out, float& c_out);
__device__ __forceinline__ void rope_elem(Frame& F, int idx, float inv) {
    float* cosa = (float*)(F.ws + WS_COSA); float* sina = (float*)(F.ws + WS_SINA); float* cosr = (float*)(F.ws + WS_COSR); float* sinr = (float*)(F.ws + WS_SINR);
    const int t = idx >> 7, i = idx & 127;
    const float ang = (float)t * inv;
    float sn, cs; sincos_f32arg(ang, sn, cs);
    cosr[idx] = cs; sinr[idx] = sn;
    if ((i & 1) == 0) { cosa[t * 64 + (i >> 1)] = cs; sina[t * 64 + (i >> 1)] = sn; }
}
template <bool TABLES>
__device__ __forceinline__ void convert_weights(Frame& F, const LayerW& L) {
    LAS float* scr = (LAS float*)(F.lds + F.wave * 16384);
    const int tgt = F.vcu * (NWAVES * 64) + F.tid, tNT = F.G * NWAVES * 64;
    int tidx = tgt; float tinv = 0.f;
    if constexpr (TABLES) { const float ex0 = (float)(2 * (tgt & 127)) / 256.0f; tinv = 1.0f / (float)exp2((double)ex0 * 13.287712379549449); }
    const int gw = F.vcu * NWAVES + F.wave, NGW = F.G * NWAVES;
    constexpr int I_GU = (D / 64) * (FF / 32), I_D = (FF / 64) * (D / 32), I_IN = (D / 64) * (INC / 32), I_PA = (AOW / 64) * (D / 32), I_PR = (RV / 64) * (D / 32), I_WO = (D / 64) * (D / 32);
    constexpr int NIT = 4 * I_GU + 2 * I_D + I_IN + I_PA + I_PR + I_WO;
    if (gw < NIT) {
        float wv[32]; f32x4 g0, g1;
        ConvItem cur = conv_decode(F, L, gw);
        conv_load(cur, F.lane, wv, g0, g1);
        for (int it = gw; it < NIT; it += NGW) {
            const bool has_next = it + NGW < NIT;
            const ConvItem nxt = conv_decode(F, L, has_next ? it + NGW : it);
            conv_to_lds(wv, scr, F.lane);
            const f32x4 c0 = g0, c1 = g1;
            if (has_next) conv_load(nxt, F.lane, wv, g0, g1);
            if constexpr (TABLES) { if (tidx < SEQ * 128) { rope_elem(F, tidx, tinv); tidx += tNT; } }
            conv_store(cur, scr, F.lane, c0, c1);
            cur = nxt;
        }
    }
    if constexpr (TABLES) { for (; tidx < SEQ * 128; tidx += tNT) rope_elem(F, tidx, tinv); }
}
__device__ __forceinline__ void sincos_f32arg(float ang, float& s_out, float& c_out) {
    const double x = (double)ang;
    const double kd = __builtin_rint(x * 0.63661977236758134308);
    double r = __builtin_fma(-kd, 1.57079632679489655800e+00, x);
    r = __builtin_fma(-kd, 6.12323399573676603587e-17, r);
    const double r2 = r * r;
    double sp = 1.0 / 6227020800.0; sp = sp * r2 - 1.0 / 39916800.0; sp = sp * r2 + 1.0 / 362880.0; sp = sp * r2 - 1.0 / 5040.0; sp = sp * r2 + 1.0 / 120.0; sp = sp * r2 - 1.0 / 6.0; sp = sp * r2 * r + r;
    double cp = -1.0 / 87178291200.0; cp = cp * r2 + 1.0 / 479001600.0; cp = cp * r2 - 1.0 / 3628800.0; cp = cp * r2 + 1.0 / 40320.0; cp = cp * r2 - 1.0 / 720.0; cp = cp * r2 + 1.0 / 24.0; cp = cp * r2 - 0.5; cp = cp * r2 + 1.0;
    const int q = ((int)kd) & 3;
    const double sv = (q == 0) ? sp : (q == 1) ? cp : (q == 2) ? -sp : -cp;
    const double cv = (q == 0) ? cp : (q == 1) ? -sp : (q == 2) ? -cp : sp;
    s_out = (float)sv; c_out = (float)cv;
}
__device__ __forceinline__ void rope_tables(Frame& F) {
    float* cosa = (float*)(F.ws + WS_COSA); float* sina = (float*)(F.ws + WS_SINA); float* cosr = (float*)(F.ws + WS_COSR); float* sinr = (float*)(F.ws + WS_SINR);
    const int gt = F.vcu * (NWAVES * 64) + F.tid, NT = F.G * NWAVES * 64;
    const bool fixed_i = (NT & 127) == 0;
    float inv0 = 0.f;
    if (fixed_i) { const float ex0 = (float)(2 * (gt & 127)) / 256.0f; inv0 = 1.0f / (float)exp2((double)ex0 * 13.287712379549449); }
    for (int idx = gt; idx < SEQ * 128; idx += NT) {
        const int t = idx >> 7, i = idx & 127;
        float inv = inv0;
        if (!fixed_i) { const float ex = (float)(2 * i) / 256.0f; inv = 1.0f / (float)exp2((double)ex * 13.287712379549449); }
        const float ang = (float)t * inv;
        float s, c; sincos_f32arg(ang, s, c);
        cosr[idx] = c; sinr[idx] = s;
        if ((i & 1) == 0) { cosa[t * 64 + (i >> 1)] = c; sina[t * 64 + (i >> 1)] = s; }
    }
}
__device__ __forceinline__ void stream_rows_input(Frame& F, const float* x, bf16* XB, unsigned long long* ssq) {
    const int gw = F.vcu * NWAVES + F.wave, NGW = F.G * NWAVES;
    for (int m = gw; m < M; m += NGW) {
        const f32x4* xr = (const f32x4*)(x + (size_t)m * D) + 2 * F.lane;
        f32x4 v[8]; float s = 0.f;
#pragma unroll
        for (int j = 0; j < 4; ++j) { v[2 * j] = xr[128 * j]; v[2 * j + 1] = xr[128 * j + 1]; }
#pragma unroll
        for (int j = 0; j < 8; ++j) s += (v[j].x * v[j].x + v[j].y * v[j].y) + (v[j].z * v[j].z + v[j].w * v[j].w);
        s = wave_sum(s);
        v4u* x16 = (v4u*)(XB + (size_t)m * D) + F.lane;
#pragma unroll
        for (int j = 0; j < 4; ++j) {
            const f32x4 a = v[2 * j], b = v[2 * j + 1];
            v4u c; c.x = pk2(a.x, a.y); c.y = pk2(a.z, a.w); c.z = pk2(b.x, b.y); c.w = pk2(b.z, b.w);
            x16[64 * j] = c;
        }
        if (F.lane == 0) ssq[m] = (unsigned long long)(s * pg8::SSQ_FIX);
    }
}
__device__ __forceinline__ void norm_rows_final(Frame& F, const bf16* x, const float* gain, float* out) {
    const int gw = F.vcu * NWAVES + F.wave, NGW = F.G * NWAVES;
    f32x4 gv[8];
#pragma unroll
    for (int j = 0; j < 4; ++j) { gv[2 * j] = *((const f32x4*)gain + 2 * (F.lane + 64 * j)); gv[2 * j + 1] = *((const f32x4*)gain + 2 * (F.lane + 64 * j) + 1); }
    for (int m = gw; m < M; m += NGW) {
        const v4u* xr = (const v4u*)(x + (size_t)m * D) + F.lane;
        v4u r[4]; float s = 0.f;
#pragma unroll
        for (int j = 0; j < 4; ++j) r[j] = xr[64 * j];
        f32x4 v[8];
#pragma unroll
        for (int j = 0; j < 4; ++j) { v[2 * j] = (f32x4){bf_lo(r[j].x), bf_hi(r[j].x), bf_lo(r[j].y), bf_hi(r[j].y)}; v[2 * j + 1] = (f32x4){bf_lo(r[j].z), bf_hi(r[j].z), bf_lo(r[j].w), bf_hi(r[j].w)}; }
#pragma unroll
        for (int j = 0; j < 8; ++j) s += (v[j].x * v[j].x + v[j].y * v[j].y) + (v[j].z * v[j].z + v[j].w * v[j].w);
        const float rstd = 1.0f / sqrtf(wave_sum(s) * (1.0f / D) + RMS_EPS);
        f32x4* o = (f32x4*)(out + (size_t)m * D) + 2 * F.lane;
#pragma unroll
        for (int j = 0; j < 4; ++j) { o[128 * j] = v[2 * j] * rstd * gv[2 * j]; o[128 * j + 1] = v[2 * j + 1] * rstd * gv[2 * j + 1]; }
    }
}

#define RAW_BARRIER() do { asm volatile("s_waitcnt lgkmcnt(0)" ::: "memory"); __builtin_amdgcn_s_barrier(); asm volatile("" ::: "memory"); } while (0)
typedef short v4i16_t __attribute__((ext_vector_type(4)));
__device__ __forceinline__ v4i16_t lds_tr(const LAS unsigned char* p) { return __builtin_amdgcn_ds_read_tr16_b64_v4i16((LAS v4i16_t*)p); }
__device__ __forceinline__ bf16x8 cat8(v4i16_t lo, v4i16_t hi) { return __builtin_shufflevector(lo, hi, 0, 1, 2, 3, 4, 5, 6, 7); }

constexpr int ATT_KROW = 272, ATT_VROW = 288;
constexpr int ATT_KOFF = 0, ATT_VOFF = 256 * ATT_KROW;
static_assert(ATT_VOFF + 256 * ATT_VROW <= LDSCTL_OFF, "attention LDS map");
__device__ __forceinline__ void attn_phase(Frame& F) {
    const bf16* QA = (const bf16*)(F.ws + WS_QA); const bf16* KA = (const bf16*)(F.ws + WS_KA); const bf16* VA = (const bf16*)(F.ws + WS_VA);
    bf16* OG = (bf16*)(F.ws + WS_OG); float* MLM = (float*)(F.ws + WS_MLM); float* MLL = (float*)(F.ws + WS_MLL);
    LAS unsigned char* Kl = F.lds + ATT_KOFF; LAS unsigned char* Vl = F.lds + ATT_VOFF;
    const int w = F.wave, lane = F.lane, r16 = lane & 15, g4 = lane >> 4;
#define ATT_DECODE(u_, b_, g_, hg_, d_, r_, n_, hh_) \
        const int b_ = (u_) / 1536; int rem_##b_ = (u_) - b_ * 1536; const int g_ = rem_##b_ >> 9; rem_##b_ &= 511; const int hg_ = rem_##b_ >> 7; const int blk_##b_ = rem_##b_ & 127; \
        const int dl_##b_ = 2 * g_, d_ = 1 << dl_##b_; const int nb_##b_ = 128 >> dl_##b_; const int r_ = blk_##b_ / nb_##b_, n_ = blk_##b_ - r_ * nb_##b_; const int hh_ = g_ * 4 + hg_;
#define ATT_REQUEST(u_) do { ATT_DECODE(u_, pb_, pg_, phg_, pd_, pr_, pn_, phh_) \
        _Pragma("unroll") for (int c = 0; c < 8; ++c) { const int idx = F.tid + 512 * c, kj = idx >> 4, ch = idx & 15; \
            kreg[c] = (v4u){0u, 0u, 0u, 0u}; vreg[c] = (v4u){0u, 0u, 0u, 0u}; \
            if ((pn_ > 0) || (kj >= 128)) { const int pos = ((pn_ - 1) * 128 + kj) * pd_ + pr_; const size_t off = (size_t)(pb_ * SEQ + pos) * AW + phh_ * 128 + ch * 8; kreg[c] = *(const v4u*)(KA + off); vreg[c] = *(const v4u*)(VA + off); } } \
        { const int pos = (pn_ * 128 + 16 * w + r16) * pd_ + pr_; const bf16* qp = QA + (size_t)(pb_ * SEQ + pos) * AW + phh_ * 128 + 8 * g4; \
          _Pragma("unroll") for (int ks = 0; ks < 4; ++ks) qn[ks] = *(const bf16x8*)(qp + 32 * ks); } } while (0)
#define ATT_REQUEST_OWN(u_) do { ATT_DECODE(u_, pb_, pg_, phg_, pd_, pr_, pn_, phh_) \
        _Pragma("unroll") for (int c = 0; c < 4; ++c) { const int idx = F.tid + 512 * c, kj = idx >> 4, ch = idx & 15; \
            const int pos = (pn_ * 128 + kj) * pd_ + pr_; const size_t off = (size_t)(pb_ * SEQ + pos) * AW + phh_ * 128 + ch * 8; kreg[c] = *(const v4u*)(KA + off); vreg[c] = *(const v4u*)(VA + off); } \
        { const int pos = (pn_ * 128 + 16 * w + r16) * pd_ + pr_; const bf16* qp = QA + (size_t)(pb_ * SEQ + pos) * AW + phh_ * 128 + 8 * g4; \
          _Pragma("unroll") for (int ks = 0; ks < 4; ++ks) qn[ks] = *(const bf16x8*)(qp + 32 * ks); } } while (0)
    v4u kreg[8], vreg[8]; bf16x8 qn[4];
    const bool seqmap = (3072 % F.G) == 0;
    const int nunits = seqmap ? 3072 / F.G : (F.vcu < 3072 ? (3072 - F.vcu + F.G - 1) / F.G : 0);
#define ATT_UNIT(k_) (seqmap ? F.vcu * nunits + (k_) : F.vcu + (k_) * F.G)
    if (nunits > 0) ATT_REQUEST(ATT_UNIT(0));
    int oh = 1; bool own_only = false;
    for (int k = 0; k < nunits; ++k) {
        const int u = ATT_UNIT(k);
        ATT_DECODE(u, b, g, hg, d, r, n, hh)
        (void)hh;
        if (!own_only) {
            oh = 1;
#pragma unroll
            for (int c = 0; c < 8; ++c) { const int idx = F.tid + 512 * c, kj = idx >> 4, ch = idx & 15; *(LAS v4u*)(Kl + kj * ATT_KROW + ch * 16) = kreg[c]; *(LAS v4u*)(Vl + kj * ATT_VROW + ch * 16) = vreg[c]; }
        } else {
            oh ^= 1;
#pragma unroll
            for (int c = 0; c < 4; ++c) { const int idx = F.tid + 512 * c, kj = oh * 128 + (idx >> 4), ch = idx & 15; *(LAS v4u*)(Kl + kj * ATT_KROW + ch * 16) = kreg[c]; *(LAS v4u*)(Vl + kj * ATT_VROW + ch * 16) = vreg[c]; }
        }
        bf16x8 qf[4];
#pragma unroll
        for (int ks = 0; ks < 4; ++ks) qf[ks] = qn[ks];
        bool next_own = false;
        if (k + 1 < nunits) {
            const int un = ATT_UNIT(k + 1);
            { ATT_DECODE(un, zb, zg, zhg, zd, zr, zn, zhh) (void)zb; (void)zhg; (void)zd; (void)zr; (void)zhh; next_own = seqmap && (zn > 0); }
            if (next_own) ATT_REQUEST_OWN(un); else ATT_REQUEST(un);
        }
        RAW_BARRIER();
        const int x8 = (oh ^ 1) << 3;
        f32x4 s[9];
#pragma unroll
        for (int t = 0; t < 9; ++t) {
            s[t] = (f32x4){0.f, 0.f, 0.f, 0.f};
            const LAS unsigned char* kp = Kl + (16 * ((w + t) ^ x8) + r16) * ATT_KROW + 16 * g4;
#pragma unroll
            for (int ks = 0; ks < 4; ++ks) { const bf16x8 a = *(const LAS bf16x8*)(kp + 64 * ks); s[t] = __builtin_amdgcn_mfma_f32_16x16x32_bf16(a, qf[ks], s[t], 0, 0, 0); }
        }
        const int qi = 16 * w + r16;
        float mx = -1e30f;
#pragma unroll
        for (int t = 0; t < 9; ++t)
#pragma unroll
            for (int q = 0; q < 4; ++q) { const int kj = 16 * (w + t) + 4 * g4 + q; const bool valid = (kj >= qi) && (kj <= qi + 128) && ((n > 0) || (kj >= 128)); s[t][q] = valid ? s[t][q] : -1e30f; mx = fmaxf(mx, s[t][q]); }
        mx = pg8::xor32_max(pg8::xor16_max(mx));
        float ls = 0.f;
#pragma unroll
        for (int t = 0; t < 9; ++t)
#pragma unroll
            for (int q = 0; q < 4; ++q) { const float p = (s[t][q] > -1e29f) ? __builtin_amdgcn_exp2f((s[t][q] - mx) * LOG2E) : 0.f; s[t][q] = p; ls += p; }
        ls = pg8::xor32_sum(pg8::xor16_sum(ls));
        bf16x8 pa[5];
#pragma unroll
        for (int st = 0; st < 5; ++st) {
            v4u pw;
            pw.x = pg8::cvt_pk_bf16(s[2 * st][0], s[2 * st][1]); pw.y = pg8::cvt_pk_bf16(s[2 * st][2], s[2 * st][3]);
            if (2 * st + 1 < 9) { pw.z = pg8::cvt_pk_bf16(s[2 * st + 1][0], s[2 * st + 1][1]); pw.w = pg8::cvt_pk_bf16(s[2 * st + 1][2], s[2 * st + 1][3]); } else { pw.z = 0u; pw.w = 0u; }
            pa[st] = __builtin_bit_cast(bf16x8, pw);
        }
        const LAS unsigned char* vtr = Vl + (4 * g4 + (r16 >> 2)) * ATT_VROW + (4 * (r16 & 3)) * 2;
        f32x4 o[8];
#pragma unroll
        for (int et = 0; et < 8; ++et) {
            o[et] = (f32x4){0.f, 0.f, 0.f, 0.f};
#pragma unroll
            for (int st = 0; st < 5; ++st) {
                const v4i16_t vlo = lds_tr(vtr + (16 * ((w + 2 * st) ^ x8)) * ATT_VROW + 32 * et);
                v4i16_t vhi = (v4i16_t){0, 0, 0, 0};
                if (2 * st + 1 < 9) vhi = lds_tr(vtr + (16 * ((w + 2 * st + 1) ^ x8)) * ATT_VROW + 32 * et);
                const bf16x8 vb = cat8(vlo, vhi);
                o[et] = __builtin_amdgcn_mfma_f32_16x16x32_bf16(vb, pa[st], o[et], 0, 0, 0);
            }
        }
        {
            const float linv = 1.0f / ls;
            const int pos = (n * 128 + qi) * d + r;
            bf16* op = OG + ((size_t)g * M + (size_t)(b * SEQ + pos)) * AOW + hg * 128 + 4 * g4;
#pragma unroll
            for (int et = 0; et < 8; ++et) { v2u w; w.x = pg8::cvt_pk_bf16(o[et][0] * linv, o[et][1] * linv); w.y = pg8::cvt_pk_bf16(o[et][2] * linv, o[et][3] * linv); *(v2u*)(op + 16 * et) = w; }
        }
        if (g4 == 0) {
            const int pos = (n * 128 + qi) * d + r;
            const size_t mi = ((size_t)g * M + (size_t)(b * SEQ + pos)) * 4 + hg;
            MLM[mi] = mx; MLL[mi] = ls;
        }
        RAW_BARRIER();
        own_only = next_own;
    }
}
__device__ __forceinline__ void attn_merge_rows(Frame& F) {
    const bf16* OG = (const bf16*)(F.ws + WS_OG); const float* MLM = (const float*)(F.ws + WS_MLM); const float* MLL = (const float*)(F.ws + WS_MLL);
    bf16* OA = (bf16*)(F.ws + WS_OA);
    const int gw = F.vcu * NWAVES + F.wave, NGW = F.G * NWAVES;
    const int hg = F.lane >> 4;
    for (int m0 = gw; m0 < M; m0 += 4 * NGW) {
        float mg[4][3], lg[4][3]; v4u pv[4][3];
#pragma unroll
        for (int r = 0; r < 4; ++r)
#pragma unroll
            for (int g = 0; g < 3; ++g) { const size_t row = (size_t)g * M + m0 + r * NGW; mg[r][g] = MLM[row * 4 + hg]; lg[r][g] = MLL[row * 4 + hg]; pv[r][g] = *((const v4u*)(OG + row * AOW) + F.lane); }
#pragma unroll
        for (int r = 0; r < 4; ++r) {
            const float mm = fmaxf(mg[r][0], fmaxf(mg[r][1], mg[r][2]));
            float wg[3], wsum = 0.f;
#pragma unroll
            for (int g = 0; g < 3; ++g) { wg[g] = lg[r][g] * __builtin_amdgcn_exp2f((mg[r][g] - mm) * LOG2E); wsum += wg[g]; }
            const float winv = 1.0f / wsum;
            f32x4 a0 = (f32x4){0.f, 0.f, 0.f, 0.f}, a1 = a0;
#pragma unroll
            for (int g = 0; g < 3; ++g) { const v4u p = pv[r][g];
                a0 += (f32x4){bf_lo(p.x), bf_hi(p.x), bf_lo(p.y), bf_hi(p.y)} * wg[g]; a1 += (f32x4){bf_lo(p.z), bf_hi(p.z), bf_lo(p.w), bf_hi(p.w)} * wg[g]; }
            a0 = a0 * winv; a1 = a1 * winv;
            v4u o; o.x = pk2(a0.x, a0.y); o.y = pk2(a0.z, a0.w); o.z = pk2(a1.x, a1.y); o.w = pk2(a1.z, a1.w);
            *((v4u*)(OA + (size_t)(m0 + r * NGW) * AOW) + F.lane) = o;
        }
    }
}

constexpr int RET_KROW = 528;
constexpr int RET_VROW = 96;
constexpr int RET_SROW = 528;
constexpr int RET_KOFF = 0, RET_VOFF = 128 * RET_KROW, RET_V2OFF = RET_VOFF + 128 * RET_VROW, RET_SOFF = RET_V2OFF + 128 * RET_VROW;
static_assert(RET_SOFF + 2 * 32 * RET_SROW <= LDSCTL_OFF, "retention LDS map");
__device__ __forceinline__ float ret_log2_gamma(int h) {
    return h == 0 ? -4.5803689613e-02f : h == 1 ? -2.2720076500e-02f : h == 2 ? -1.1315313228e-02f : h == 3 ? -5.6465631411e-03f
         : h == 4 ? -2.8205190624e-03f : h == 5 ? -1.4095702547e-03f : h == 6 ? -7.0461297659e-04f : -3.5226347163e-04f;
}
__device__ __forceinline__ void retention_scores_phase(Frame& F) {
    const bf16* QR = (const bf16*)(F.ws + WS_QR); const bf16* KR = (const bf16*)(F.ws + WS_KR); bf16* PB = (bf16*)(F.ws + WS_PR);
    LAS unsigned char* Kl = F.lds + RET_KOFF;
    const int w = F.wave, lane = F.lane, r16 = lane & 15, g4 = lane >> 4;
    const int it = (w < 4) ? w : 11 - w;
    const int krow = F.tid >> 5, kch = F.tid & 31;
    const LAS unsigned char* k_row = Kl + r16 * RET_KROW + 16 * g4;
    const int iq = 16 * it + r16;
#define R0_REQUEST(u_) do { const int bh_ = (u_) >> 7, n_ = (u_) & 127; const size_t m_ = (size_t)bh_ * SEQ + (size_t)n_ * 128; \
        _Pragma("unroll") for (int c = 0; c < 8; ++c) kreg[c] = *(const v4u*)(KR + (m_ + krow + 16 * c) * 256 + kch * 8); \
        { const bf16* qp = QR + (m_ + 16 * it) * 256 + lane * 8; _Pragma("unroll") for (int ks = 0; ks < 8; ++ks) qn[ks] = *(const bf16x8*)(qp + 512 * ks); } } while (0)
    v4u kreg[8]; bf16x8 qn[8];
    if (F.vcu < 2048) R0_REQUEST(F.vcu);
    for (int u = F.vcu; u < 2048; u += F.G) {
        const int bh = u >> 7, n = u & 127, h = bh & 7;
        const float l2g = ret_log2_gamma(h);
        const size_t m0 = (size_t)bh * SEQ + (size_t)n * 128;
#pragma unroll
        for (int c = 0; c < 8; ++c) *(LAS v4u*)(Kl + (krow + 16 * c) * RET_KROW + kch * 16) = kreg[c];
        bf16x8 qf[8];
#pragma unroll
        for (int ks = 0; ks < 8; ++ks) qf[ks] = qn[ks];
        { const int un = (u + F.G < 2048) ? u + F.G : u; if (un != u) R0_REQUEST(un); }
        RAW_BARRIER();
        { const LAS unsigned char* k_tr = Kl + (4 * g4 + (r16 >> 2)) * RET_KROW + (32 * w + 4 * (r16 & 3)) * 2;
          bf16* kw = (bf16*)KR + m0 * 256 + (size_t)(w * 8) * 512 + lane * 8;
#pragma unroll
          for (int ks = 0; ks < 4; ++ks) {
              float fd[8];
#pragma unroll
              for (int j = 0; j < 8; ++j) fd[j] = __builtin_amdgcn_exp2f((float)(127 - (32 * ks + 16 * (j >> 2) + 4 * g4 + (j & 3))) * l2g);
#pragma unroll
              for (int a = 0; a < 2; ++a) {
                  const v4i16_t lo = lds_tr(k_tr + (32 * ks) * RET_KROW + 32 * a), hi = lds_tr(k_tr + (32 * ks + 16) * RET_KROW + 32 * a);
                  v4u o;
                  o.x = pg8::cvt_pk_bf16(bf_lo((unsigned)(unsigned short)lo[0]) * fd[0], bf_lo((unsigned)(unsigned short)lo[1]) * fd[1]);
                  o.y = pg8::cvt_pk_bf16(bf_lo((unsigned)(unsigned short)lo[2]) * fd[2], bf_lo((unsigned)(unsigned short)lo[3]) * fd[3]);
                  o.z = pg8::cvt_pk_bf16(bf_lo((unsigned)(unsigned short)hi[0]) * fd[4], bf_lo((unsigned)(unsigned short)hi[1]) * fd[5]);
                  o.w = pg8::cvt_pk_bf16(bf_lo((unsigned)(unsigned short)hi[2]) * fd[6], bf_lo((unsigned)(unsigned short)hi[3]) * fd[7]);
                  *(v4u*)(kw + (size_t)(4 * a + ks) * 512) = o;
              }
          } }
        bf16* pw_base = PB + (((size_t)u * 8 + it) * 4) * 512 + lane * 8;
#pragma unroll
        for (int sp = 0; sp < 4; ++sp) {
            if (2 * sp <= it) {
                f32x4 sc2[2];
#pragma unroll
                for (int hh = 0; hh < 2; ++hh) {
                    const int jt = 2 * sp + hh;
                    sc2[hh] = (f32x4){0.f, 0.f, 0.f, 0.f};
                    if (jt <= it) {
#pragma unroll
                        for (int ks = 0; ks < 8; ++ks) { const bf16x8 a = *(const LAS bf16x8*)(k_row + (16 * jt) * RET_KROW + 64 * ks); sc2[hh] = __builtin_amdgcn_mfma_f32_16x16x32_bf16(a, qf[ks], sc2[hh], 0, 0, 0); }
#pragma unroll
                        for (int q = 0; q < 4; ++q) { const int j = 16 * jt + 4 * g4 + q; sc2[hh][q] = (iq >= j) ? sc2[hh][q] * __builtin_amdgcn_exp2f((float)(iq - j) * l2g) : 0.f; }
                    }
                }
                v4u pw; pw.x = pg8::cvt_pk_bf16(sc2[0][0], sc2[0][1]); pw.y = pg8::cvt_pk_bf16(sc2[0][2], sc2[0][3]); pw.z = pg8::cvt_pk_bf16(sc2[1][0], sc2[1][1]); pw.w = pg8::cvt_pk_bf16(sc2[1][2], sc2[1][3]);
                *(v4u*)(pw_base + 512 * sp) = pw;
            }
        }
        RAW_BARRIER();
    }
#undef R0_REQUEST
}
constexpr int RS_VOFF = 0, RS_SOFF = 2 * 128 * RET_VROW;
__device__ __forceinline__ void retention_phase(Frame& F) {
    const bf16* QR = (const bf16*)(F.ws + WS_QR); const bf16* KR = (const bf16*)(F.ws + WS_KR); bf16* VR = (bf16*)(F.ws + WS_VR); const bf16* PB = (const bf16*)(F.ws + WS_PR);
    LAS unsigned char* Vl = F.lds + RS_VOFF; LAS unsigned char* Sl = F.lds + RS_SOFF;
    const int w = F.wave, lane = F.lane, r16 = lane & 15, g4 = lane >> 4, trq = r16 >> 2, trp = r16 & 3;
    const int it = (w < 4) ? w : 11 - w;
    const int vrow = F.tid >> 2, vch = F.tid & 3;
    for (int u = F.vcu; u < 256; u += F.G) {
        const int bh = u >> 4, sl = u & 15, h = bh & 7;
        const float l2g = ret_log2_gamma(h);
        const float gC = __builtin_amdgcn_exp2f(128.0f * l2g);
        const float oscale = __builtin_amdgcn_exp2f((float)(16 * it + r16 + 1) * l2g);
        bf16* vg = VR + (((size_t)bh * 16 + sl) * SEQ + vrow) * 32 + vch * 8;
        const bf16* qg = QR + ((size_t)bh * SEQ + 16 * it) * 256 + lane * 8;
        const bf16* kg = KR + ((size_t)bh * SEQ) * 256 + (size_t)(w * 8) * 512 + lane * 8;
        const bf16* pg = PB + (((size_t)(bh * 128) * 8 + it) * 4) * 512 + lane * 8;
        bf16* og = VR + (((size_t)bh * 16 + sl) * SEQ + 16 * it + r16) * 32 + 4 * g4;
        f32x4 st[2][2];
#pragma unroll
        for (int a = 0; a < 2; ++a)
#pragma unroll
            for (int e = 0; e < 2; ++e) st[a][e] = (f32x4){0.f, 0.f, 0.f, 0.f};
        for (int i = F.tid; i < 32 * RET_SROW / 4; i += NWAVES * 64) ((LAS unsigned*)Sl)[i] = 0u;
        v4u vreg; bf16x8 qf[8], pf[4], kf[8];
        vreg = *(const v4u*)vg;
#pragma unroll
        for (int ks = 0; ks < 8; ++ks) qf[ks] = *(const bf16x8*)(qg + 512 * ks);
#pragma unroll
        for (int s = 0; s < 4; ++s) { pf[s] = (bf16x8){0, 0, 0, 0, 0, 0, 0, 0}; if (2 * s <= it) pf[s] = *(const bf16x8*)(pg + 512 * s); }
#pragma unroll
        for (int f = 0; f < 8; ++f) kf[f] = *(const bf16x8*)(kg + 512 * f);
        *(LAS v4u*)(Vl + vrow * RET_VROW + vch * 16) = vreg;
        __syncthreads();
        const int v_pv = (4 * g4 + trq) * RET_VROW + (4 * trp) * 2;
        for (int n = 0; n < 128; ++n) {
            const int cur = n & 1;
            const LAS unsigned char* Vc = Vl + cur * (128 * RET_VROW); LAS unsigned char* Vn = Vl + (cur ^ 1) * (128 * RET_VROW);
            const LAS unsigned char* Sc = Sl + cur * (32 * RET_SROW); LAS unsigned char* Sn = Sl + (cur ^ 1) * (32 * RET_SROW);
            const size_t nrow = (size_t)((n < 127 ? n + 1 : n) * 128);
            vreg = *(const v4u*)(vg + nrow * 32);
            f32x4 o[2]; bf16x8 sb[2][8];
#pragma unroll
            for (int et = 0; et < 2; ++et) {
                const LAS unsigned char* sp = Sc + (16 * et + r16) * RET_SROW + 16 * g4;
#pragma unroll
                for (int ks = 0; ks < 8; ++ks) sb[et][ks] = *(const LAS bf16x8*)(sp + 64 * ks);
            }
            __builtin_amdgcn_sched_barrier(0);
            o[0] = (f32x4){0.f, 0.f, 0.f, 0.f}; o[1] = o[0];
#pragma unroll
            for (int ks = 0; ks < 8; ++ks)
#pragma unroll
                for (int et = 0; et < 2; ++et) o[et] = __builtin_amdgcn_mfma_f32_16x16x32_bf16(sb[et][ks], qf[ks], o[et], 0, 0, 0);
#pragma unroll
            for (int ks = 0; ks < 8; ++ks) qf[ks] = *(const bf16x8*)(qg + nrow * 256 + 512 * ks);
            bf16x8 vfr[4][2];
#pragma unroll
            for (int ks = 0; ks < 4; ++ks)
#pragma unroll
                for (int et = 0; et < 2; ++et) vfr[ks][et] = cat8(lds_tr(Vc + v_pv + (32 * ks) * RET_VROW + 32 * et), lds_tr(Vc + v_pv + (32 * ks + 16) * RET_VROW + 32 * et));
            __builtin_amdgcn_sched_barrier(0);
            o[0] = o[0] * oscale; o[1] = o[1] * oscale;
#pragma unroll
            for (int s = 0; s < 4; ++s) {
                if (2 * s <= it) {
#pragma unroll
                    for (int et = 0; et < 2; ++et) o[et] = __builtin_amdgcn_mfma_f32_16x16x32_bf16(vfr[s][et], pf[s], o[et], 0, 0, 0);
                    pf[s] = *(const bf16x8*)(pg + nrow * 128 + 512 * s);
                }
            }
            {
                bf16* op = og + (size_t)n * 128 * 32;
                v2u w0; w0.x = pg8::cvt_pk_bf16(o[0][0], o[0][1]); w0.y = pg8::cvt_pk_bf16(o[0][2], o[0][3]);
                v2u w1; w1.x = pg8::cvt_pk_bf16(o[1][0], o[1][1]); w1.y = pg8::cvt_pk_bf16(o[1][2], o[1][3]);
                *(v2u*)op = w0; *(v2u*)(op + 16) = w1;
            }
#pragma unroll
            for (int a = 0; a < 2; ++a)
#pragma unroll
                for (int et = 0; et < 2; ++et) st[a][et] = st[a][et] * gC;
#pragma unroll
            for (int ks = 0; ks < 4; ++ks)
#pragma unroll
                for (int a = 0; a < 2; ++a)
#pragma unroll
                    for (int et = 0; et < 2; ++et) st[a][et] = __builtin_amdgcn_mfma_f32_16x16x32_bf16(kf[4 * a + ks], vfr[ks][et], st[a][et], 0, 0, 0);
#pragma unroll
            for (int f = 0; f < 8; ++f) kf[f] = *(const bf16x8*)(kg + nrow * 256 + 512 * f);
#pragma unroll
            for (int a = 0; a < 2; ++a)
#pragma unroll
                for (int et = 0; et < 2; ++et) {
                    v2u wv; wv.x = pg8::cvt_pk_bf16(st[a][et][0], st[a][et][1]); wv.y = pg8::cvt_pk_bf16(st[a][et][2], st[a][et][3]);
                    *(LAS v2u*)(Sn + (16 * et + r16) * RET_SROW + (32 * w + 16 * a + 4 * g4) * 2) = wv;
                }
            *(LAS v4u*)(Vn + vrow * RET_VROW + vch * 16) = vreg;
            RAW_BARRIER();
        }
        __syncthreads();
    }
}
__device__ __forceinline__ void retention_stats_rows(Frame& F) {
    const bf16* VR = (const bf16*)(F.ws + WS_VR); float* st = (float*)(F.ws + WS_GST);
    const int gw = F.vcu * NWAVES + F.wave, NGW = F.G * NWAVES;
    for (int t0 = gw; t0 < M * 8; t0 += 4 * NGW) {
        v4u ov[4];
#pragma unroll
        for (int r = 0; r < 4; ++r) {
            const int t = t0 + r * NGW;
            const int mm = t >> 3, hh = t & 7, bb = mm / SEQ, tt = mm - bb * SEQ;
            ov[r] = *(const v4u*)(VR + ((((size_t)(bb * 8 + hh) * 16 + (F.lane >> 2)) * SEQ + tt) * 32 + (F.lane & 3) * 8));
        }
#pragma unroll
        for (int r = 0; r < 4; ++r) {
            float x[8] = {bf_lo(ov[r].x), bf_hi(ov[r].x), bf_lo(ov[r].y), bf_hi(ov[r].y), bf_lo(ov[r].z), bf_hi(ov[r].z), bf_lo(ov[r].w), bf_hi(ov[r].w)};
            float sm = 0.f;
#pragma unroll
            for (int j = 0; j < 8; ++j) sm += x[j];
            const float mu = wave_sum(sm) * (1.0f / 512.0f);
            float q = 0.f;
#pragma unroll
            for (int j = 0; j < 8; ++j) { x[j] -= mu; q += x[j] * x[j]; }
            const float rstd = 1.0f / sqrtf(wave_sum(q) * (1.0f / 512.0f) + GN_EPS);
            if (F.lane == 0) { pg8::f32x2_t o = {mu, rstd}; *(pg8::f32x2_t*)(st + (size_t)(t0 + r * NGW) * 2) = o; }
        }
    }
}

constexpr int PH_PER_LAYER = 17;
constexpr int N_PHASES = DEPTH * PH_PER_LAYER + 1;
constexpr int PTRS_OFF = LDSCTL_OFF + 64;
struct Args { const float* in[15]; float* out; unsigned char* ws; int ph_lo, ph_hi, li, pad; };
__device__ __forceinline__ unsigned char* ldptr(LAS unsigned char* lds, int k) {
    volatile LAS unsigned* p = (volatile LAS unsigned*)(lds + PTRS_OFF + 8 * k);
    const unsigned lo = __builtin_amdgcn_readfirstlane(p[0]), hi = __builtin_amdgcn_readfirstlane(p[1]);
    GAS unsigned char* g = (GAS unsigned char*)(((unsigned long long)hi << 32) | lo);
    return (unsigned char*)g;
}
__device__ __forceinline__ void make_frame(Frame& F, LAS unsigned char* lds) {
    int tid = threadIdx.x; asm volatile("" : "+v"(tid));
    int bx = blockIdx.x; asm volatile("" : "+s"(bx));
    int G = gridDim.x; asm volatile("" : "+s"(G));
    F.lds = lds; F.tid = tid; F.lane = tid & 63; F.wave = __builtin_amdgcn_readfirstlane(tid >> 6);
    F.G = G; F.bx = bx; F.vcu = (G % 8 == 0) ? (bx % 8) * (G / 8) + bx / 8 : bx;
    F.ws = ldptr(lds, 16);
}
#define IN_PTR(k) ((const float*)ldptr(F.lds, (k)))
#define OUT_PTR() ((float*)ldptr(F.lds, 15))
#define SSQ_PTR(j) ((unsigned long long*)(F.ws + WS_SSQ + (size_t)(j) * SSQ_BYTES))
#define XB_PTR() ((bf16*)ldptr(F.lds, 15))

__device__ __forceinline__ void ph_prologue(LAS unsigned char* lds, int layer) {
    Frame F; make_frame(F, lds);
    LayerW L;
    L.g1 = IN_PTR(2) + (size_t)layer * D * FF; L.u1 = IN_PTR(3) + (size_t)layer * D * FF; L.d1 = IN_PTR(4) + (size_t)layer * FF * D;
    L.win = IN_PTR(6) + (size_t)layer * D * INC; L.pa = IN_PTR(7) + (size_t)layer * AOW * D; L.pr = IN_PTR(8) + (size_t)layer * RV * D; L.wo = IN_PTR(9) + (size_t)layer * D * D;
    L.g2 = IN_PTR(11) + (size_t)layer * D * FF; L.u2 = IN_PTR(12) + (size_t)layer * D * FF; L.d2 = IN_PTR(13) + (size_t)layer * FF * D;
    L.n1 = IN_PTR(1) + (size_t)layer * D; L.nm = IN_PTR(5) + (size_t)layer * D; L.n2 = IN_PTR(10) + (size_t)layer * D;
    convert_weights<false>(F, L);
}
__device__ __forceinline__ void ph_prologue0(LAS unsigned char* lds) {
    Frame F; make_frame(F, lds);
    LayerW L;
    L.g1 = IN_PTR(2); L.u1 = IN_PTR(3); L.d1 = IN_PTR(4); L.win = IN_PTR(6); L.pa = IN_PTR(7); L.pr = IN_PTR(8); L.wo = IN_PTR(9); L.g2 = IN_PTR(11); L.u2 = IN_PTR(12); L.d2 = IN_PTR(13);
    L.n1 = IN_PTR(1); L.nm = IN_PTR(5); L.n2 = IN_PTR(10);
    convert_weights<true>(F, L);
    stream_rows_input(F, IN_PTR(0), XB_PTR(), SSQ_PTR(0));
}
__device__ __forceinline__ void ph_tables(LAS unsigned char* lds) {
    Frame F; make_frame(F, lds);
    unsigned long long* z = SSQ_PTR(1);
    for (int i = F.vcu * (NWAVES * 64) + F.tid; i < 3 * DEPTH * M; i += F.G * NWAVES * 64) z[i] = 0ull;
}
__device__ __forceinline__ void ph_gateup(LAS unsigned char* lds, size_t w_off, int site) {
    Frame F; make_frame(F, lds);
    pg8::Gemm g{XB_PTR(), (const bf16*)(F.ws + w_off), M, 2 * FF, D}; pg8::StaticOrder S; S.init(M, 2 * FF, F.G, F.bx);
    pg8::EpiGateUp E{(bf16*)(F.ws + WS_HID), FF, SSQ_PTR(site)};
    pg8::gemm_phase<pg8::EpiGateUp, pg8::StaticOrder>(F.lds, F.tid, g, S, E);
}
__device__ __forceinline__ void ph_res(LAS unsigned char* lds, size_t a_off, size_t w_off, int K, float scale, bool last, int site, int rev, int a_tiled) {
    Frame F; make_frame(F, lds);
    const bf16* base = XB_PTR(); bf16* xout = last ? (bf16*)(F.ws + WS_H) : XB_PTR();
    pg8::Gemm g{(const bf16*)(F.ws + a_off), (const bf16*)(F.ws + w_off), M, D, K, a_tiled}; pg8::StaticOrder S; S.init(M, D, F.G, F.bx, 4, rev);
    pg8::EpiRes E{base, xout, D, scale, SSQ_PTR(site)};
    pg8::gemm_phase<pg8::EpiRes, pg8::StaticOrder>(F.lds, F.tid, g, S, E);
}
__device__ __forceinline__ void ph_in_a(LAS unsigned char* lds, int site) {
    Frame F; make_frame(F, lds);
    pg8::Gemm g{XB_PTR(), (const bf16*)(F.ws + WS_WIN), M, 3 * AW, D}; pg8::StaticOrder S; S.init(M, 3 * AW, F.G, F.bx);
    pg8::EpiInA E{(bf16*)(F.ws + WS_QA), (WS_KA - WS_QA) / 2, (const float*)(F.ws + WS_COSA), (const float*)(F.ws + WS_SINA), SEQ, SSQ_PTR(site)};
    pg8::gemm_phase<pg8::EpiInA, pg8::StaticOrder>(F.lds, F.tid, g, S, E);
}
__device__ __forceinline__ void ph_in_r(LAS unsigned char* lds, int site) {
    Frame F; make_frame(F, lds);
    pg8::Gemm g{XB_PTR(), (const bf16*)(F.ws + WS_WIN) + (size_t)(3 * AW) * D, M, 2 * RQK + RV, D}; pg8::StaticOrder S; S.init(M, 2 * RQK + RV, F.G, F.bx);
    pg8::EpiInR E{(bf16*)(F.ws + WS_QR), (WS_KR - WS_QR) / 2, (bf16*)(F.ws + WS_VR), (WS_OR - WS_VR) / 2, (const float*)(F.ws + WS_COSR), (const float*)(F.ws + WS_SINR), SEQ, SSQ_PTR(site)};
    pg8::gemm_phase<pg8::EpiInR, pg8::StaticOrder>(F.lds, F.tid, g, S, E);
}
__device__ __forceinline__ void ph_in_g(LAS unsigned char* lds, int site) {
    Frame F; make_frame(F, lds);
    pg8::Gemm g{XB_PTR(), (const bf16*)(F.ws + WS_WIN) + (size_t)(3 * AW + 2 * RQK + 2 * RV) * D, M, 2 * D, D}; pg8::StaticOrder S; S.init(M, 2 * D, F.G, F.bx);
    pg8::EpiGates E{(bf16*)(F.ws + WS_SGA), (WS_SGB - WS_SGA) / 2, SSQ_PTR(site)};
    pg8::gemm_phase<pg8::EpiGates, pg8::StaticOrder>(F.lds, F.tid, g, S, E);
}
__device__ __forceinline__ void ph_gated(LAS unsigned char* lds, size_t a_off, size_t w_off, int K, size_t gate_off, bool has_add, size_t add_off) {
    Frame F; make_frame(F, lds);
    pg8::Gemm g{(const bf16*)(F.ws + a_off), (const bf16*)(F.ws + w_off), M, D, K}; pg8::StaticOrder S; S.init(M, D, F.G, F.bx, 4);
    pg8::EpiGated E{(const bf16*)(F.ws + gate_off), has_add ? (const bf16*)(F.ws + add_off) : nullptr, (bf16*)(F.ws + gate_off), D};
    pg8::gemm_phase<pg8::EpiGated, pg8::StaticOrder>(F.lds, F.tid, g, S, E);
}
__device__ __forceinline__ void ph_attn(LAS unsigned char* lds) { Frame F; make_frame(F, lds); attn_phase(F); }
__device__ __forceinline__ void ph_attn_merge(LAS unsigned char* lds) { Frame F; make_frame(F, lds); attn_merge_rows(F); }
__device__ __forceinline__ void ph_ret_scores(LAS unsigned char* lds) { Frame F; make_frame(F, lds); retention_scores_phase(F); }
__device__ __forceinline__ void ph_ret(LAS unsigned char* lds) { Frame F; make_frame(F, lds); retention_phase(F); }
__device__ __forceinline__ void ph_ret_stats(LAS unsigned char* lds) { Frame F; make_frame(F, lds); retention_stats_rows(F); }
__device__ __forceinline__ void ph_g(LAS unsigned char* lds, int site) {
    Frame F; make_frame(F, lds);
    pg8::Gemm g{XB_PTR(), (const bf16*)(F.ws + WS_WIN) + (size_t)(3 * AW + 2 * RQK + RV) * D, M, RV, D}; pg8::StaticOrder S; S.init(M, RV, F.G, F.bx);
    static_assert(pg8::EpiG::seq == SEQ, "EpiG seq");
    pg8::EpiG E{(const bf16*)(F.ws + WS_VR), (bf16*)(F.ws + WS_OR), (const float*)(F.ws + WS_GST), SSQ_PTR(site)};
    pg8::gemm_phase<pg8::EpiG, pg8::StaticOrder>(F.lds, F.tid, g, S, E);
}
__device__ __forceinline__ void ph_final(LAS unsigned char* lds) { Frame F; make_frame(F, lds); norm_rows_final(F, (const bf16*)(F.ws + WS_H), IN_PTR(14), OUT_PTR()); }

#ifndef PHMASK
#define PHMASK 0x1ffff
#endif
__global__ void __launch_bounds__(NWAVES * 64, 2) fwd_kernel(Args args) {
    extern __shared__ __attribute__((aligned(16))) unsigned char lds_raw[];
    LAS unsigned char* lds = (LAS unsigned char*)lds_raw;
    for (int u = threadIdx.x; u < (LDS_BYTES - LDSCTL_OFF) / 4; u += NWAVES * 64) ((LAS unsigned*)(lds + LDSCTL_OFF))[u] = 0u;
    __syncthreads();
    if (threadIdx.x < 17) {
        const int k = threadIdx.x;
        unsigned long long v = (k < 15) ? (unsigned long long)args.in[k < 15 ? k : 0] : (k == 15 ? (unsigned long long)args.out : (unsigned long long)args.ws);
        *(LAS unsigned long long*)(lds + PTRS_OFF + 8 * k) = v;
    }
    __syncthreads();
    volatile LAS unsigned* MISC = (volatile LAS unsigned*)(lds + MISC_OFF);
    XcdBarrier bar = xcd_barrier_post((unsigned*)(ldptr(lds, 16) + WS_CTL) + CW_BAR + args.li * XCD_BAR_WORDS, MISC + 8);
    const int lo = args.ph_lo, hi = args.ph_hi;
#define IN(k) (((PHMASK >> (((k) - pb) & 31)) & 1) && lo <= (k) && (k) < hi)
#define SEAM(k) do { if ((k) + 1 < hi) xcd_barrier(bar); } while (0)
    { const int pb = 0; if (IN(0)) { ph_tables(lds); ph_prologue0(lds); SEAM(0); } }
#define RUN(k, call) do { if (IN(pb + (k))) { call; SEAM(pb + (k)); } } while (0)
    for (int layer = 0; layer < DEPTH; ++layer) {
        const int pb = layer * PH_PER_LAYER;
        if (layer > 0) RUN(0, ph_prologue(lds, layer));
        RUN(1, ph_gateup(lds, WS_WGU1, 3 * layer));
        RUN(2, ph_res(lds, WS_HID, WS_WD1, FF, 0.5f, false, 3 * layer + 1, 1, 1));
        RUN(4, ph_in_a(lds, 3 * layer + 1));
        RUN(5, ph_attn(lds));
        if (IN(pb + 7)) { ph_attn_merge(lds); ph_in_r(lds, 3 * layer + 1); SEAM(pb + 7); }
        if (IN(pb + 8)) { ph_ret_scores(lds); xcd_barrier(bar); ph_ret(lds); SEAM(pb + 8); }
        if (IN(pb + 9)) { ph_ret_stats(lds); ph_in_g(lds, 3 * layer + 1); SEAM(pb + 9); }
        RUN(10, ph_g(lds, 3 * layer + 1));
        if (IN(pb + 12)) {
            ph_gated(lds, WS_OA, WS_WPA, AOW, WS_SGA, false, 0);
            ph_gated(lds, WS_OR, WS_WPR, RV, WS_SGB, true, WS_SGA);
            SEAM(pb + 12);
        }
        RUN(13, ph_res(lds, WS_SGB, WS_WOUT, D, 1.0f, false, 3 * layer + 2, 0, 0));
        RUN(15, ph_gateup(lds, WS_WGU2, 3 * layer + 2));
        RUN(16, ph_res(lds, WS_HID, WS_WD2, FF, 0.5f, layer == DEPTH - 1, 3 * layer + 3, 1, 1));
    }
    { const int pb = DEPTH * PH_PER_LAYER; if (IN(pb)) ph_final(lds); }
#undef RUN
#undef IN
#undef SEAM
}

#ifndef MK_PER_PHASE
#define MK_PER_PHASE 0
#endif
extern "C" void kernel_launch(void* const* d_in, const int* in_sizes, int n_in, void* d_out, int out_size, void* d_ws, size_t ws_size, hipStream_t stream) {
    static int grid = 0;
    if (grid == 0) {
        if (n_in != 15 || out_size != M * D || ws_size < WS_END) { fprintf(stderr, "kernel_launch: unexpected shapes (n_in %d, out %d, ws %zu)\n", n_in, out_size, ws_size); grid = -1; return; }
        int dev = 0, cus = 0, per_cu = 0;
        if (hipGetDevice(&dev) != hipSuccess || hipDeviceGetAttribute(&cus, hipDeviceAttributeMultiprocessorCount, dev) != hipSuccess) { grid = -1; return; }
        if (hipFuncSetAttribute((const void*)fwd_kernel, hipFuncAttributeMaxDynamicSharedMemorySize, LDS_BYTES) != hipSuccess) { fprintf(stderr, "kernel_launch: hipFuncSetAttribute failed\n"); grid = -1; return; }
        if (hipOccupancyMaxActiveBlocksPerMultiprocessor(&per_cu, (const void*)fwd_kernel, NWAVES * 64, LDS_BYTES) != hipSuccess || per_cu < 1) fprintf(stderr, "kernel_launch: occupancy query reports %d\n", per_cu);
        (void)hipGetLastError();
        grid = cus;
    }
    if (grid < 0) return;
    (void)hipMemsetAsync((char*)d_ws + WS_CTL, 0, CTL_ZERO_BYTES, stream);
    Args a{};
    for (int i = 0; i < 15; ++i) a.in[i] = (const float*)d_in[i];
    a.out = (float*)d_out; a.ws = (unsigned char*)d_ws;
#if MK_PER_PHASE
    for (int p = 0; p < N_PHASES; ++p) { a.ph_lo = p; a.ph_hi = p + 1; a.li = p; hipLaunchKernelGGL(fwd_kernel, dim3(grid), dim3(NWAVES * 64), LDS_BYTES, stream, a); }
#else
    a.ph_lo = 0; a.ph_hi = N_PHASES; a.li = 0;
    hipLaunchKernelGGL(fwd_kernel, dim3(grid), dim3(NWAVES * 64), LDS_BYTES, stream, a);
#endif
}
```
